# Optimizing an MI355X kernel written in HIP

```python
import math
import jax, jax.numpy as jnp
from jax import lax
import numpy as np

D_MODEL = 1024
BATCH = 8
SEQ = 4096
DEPTH = 1

GRID_W = 64
CTX_LEN = 256
HEAD_DIM = 64
ROPE_THETA = 10000.0
NORM_EPS = 1e-6
Q_BLOCK = 128
DIFF_HEADS = 4
DIFF_V_DIM = 2 * HEAD_DIM
DIFF_WIDTH = DIFF_HEADS * DIFF_V_DIM
GQA_Q_HEADS = 8
GQA_KV_HEADS = 2
GQA_GROUP = GQA_Q_HEADS // GQA_KV_HEADS
GQA_WIDTH = GQA_Q_HEADS * HEAD_DIM
MIX_WIDTH = DIFF_WIDTH + GQA_WIDTH
GQA_KV_WIDTH = GQA_KV_HEADS * HEAD_DIM
IN_COLS = 3 * DIFF_WIDTH + GQA_WIDTH + 2 * GQA_KV_WIDTH
_IN_SPLITS = (DIFF_WIDTH, 2 * DIFF_WIDTH, 3 * DIFF_WIDTH,
              3 * DIFF_WIDTH + GQA_WIDTH, 3 * DIFF_WIDTH + GQA_WIDTH + GQA_KV_WIDTH)
PEER_HEADS = 8
PEER_N_KEYS = 128
PEER_N_EXPERTS = PEER_N_KEYS * PEER_N_KEYS
PEER_QUERY_DIM = 256
PEER_HALF = PEER_QUERY_DIM // 2
PEER_TOPK = 16
PEER_CHUNK = 128

kernel_name = "hymba_diffattn_gqa_peer_dit"


def rmsnorm(x, g):
    xf = x.astype(jnp.float32)
    y = xf * lax.rsqrt(jnp.mean(xf * xf, axis=-1, keepdims=True) + NORM_EPS)
    return (y * g.astype(jnp.float32)).astype(x.dtype)


def modulate(h, shift, scale):
    return h * (1 + scale) + shift


def _rope_axis(x, pos):
    d = x.shape[-1]
    half = d // 2
    freqs = ROPE_THETA ** (-jnp.arange(half, dtype=jnp.float32) / half)
    ang = pos.astype(jnp.float32)[:, None] * freqs[None, :]
    shape = (1, x.shape[1]) + (1,) * (x.ndim - 3) + (half,)
    cos = jnp.cos(ang).reshape(shape).astype(x.dtype)
    sin = jnp.sin(ang).reshape(shape).astype(x.dtype)
    x1, x2 = x[..., :half], x[..., half:]
    return jnp.concatenate([x1 * cos - x2 * sin, x1 * sin + x2 * cos], axis=-1)


def rope2d(x):
    n = x.shape[1]
    rows = n // GRID_W
    row_pos = jnp.broadcast_to(jnp.arange(rows, dtype=jnp.int32)[:, None], (rows, GRID_W)).reshape(-1)
    col_pos = jnp.broadcast_to(jnp.arange(GRID_W, dtype=jnp.int32)[None, :], (rows, GRID_W)).reshape(-1)
    d = x.shape[-1] // 2
    return jnp.concatenate([_rope_axis(x[..., :d], row_pos), _rope_axis(x[..., d:], col_pos)], axis=-1)


def attend(q, k, v):
    B, S, Hk, G, d = q.shape
    nb = S // Q_BLOCK
    qb = q.reshape(B, nb, Q_BLOCK, Hk, G, d).swapaxes(0, 1)
    scale = d ** -0.5

    def one(qblk):
        s = jnp.einsum('bqhgd,bkhd->bhgqk', qblk, k, preferred_element_type=jnp.float32) * scale
        p = jax.nn.softmax(s, axis=-1).astype(v.dtype)
        return jnp.einsum('bhgqk,bkhe->bqhge', p, v)

    o = lax.map(one, qb)
    return o.swapaxes(0, 1).reshape(B, S, Hk, G, v.shape[-1])


def _mixer_heads(p):
    B, S, _ = p.shape
    dq, dk, dv, gq, gk, gv = jnp.split(p, _IN_SPLITS, axis=-1)
    return (dq.reshape(B, S, DIFF_HEADS, 2, HEAD_DIM),
            dk.reshape(B, S, DIFF_HEADS, 2, HEAD_DIM),
            dv.reshape(B, S, DIFF_HEADS, DIFF_V_DIM),
            gq.reshape(B, S, GQA_Q_HEADS, HEAD_DIM),
            gk.reshape(B, S, GQA_KV_HEADS, HEAD_DIM),
            gv.reshape(B, S, GQA_KV_HEADS, HEAD_DIM))


def _mix_queries(dq, gq, dk, dv, gk, gv, lam, lambda_init, subln_g, w_out):
    B, S = dq.shape[:2]
    o1 = attend(dq[:, :, :, 0, None, :], dk[:, :, :, 0, :], dv)
    o2 = attend(dq[:, :, :, 1, None, :], dk[:, :, :, 1, :], dv)
    od = (o1 - lam.astype(o1.dtype) * o2)[:, :, :, 0, :]
    od = rmsnorm(od, subln_g) * (1.0 - lambda_init)
    og = attend(gq.reshape(B, S, GQA_KV_HEADS, GQA_GROUP, HEAD_DIM), gk, gv)
    o = jnp.concatenate([od.reshape(B, S, DIFF_WIDTH), og.reshape(B, S, GQA_WIDTH)], axis=-1)
    return o @ w_out


def peer(h, w_q, subkeys, u, v):
    B, S, D = h.shape
    xs = h.reshape(-1, PEER_CHUNK, D)

    def one(xc):
        C = xc.shape[0]
        q = (xc @ w_q).reshape(C, PEER_HEADS, 2, PEER_HALF)
        s = jnp.einsum('chpd,hpnd->chpn', q, subkeys, preferred_element_type=jnp.float32)
        sv, si = lax.top_k(s, PEER_TOPK)
        cand = sv[:, :, 0, :, None] + sv[:, :, 1, None, :]
        cand_id = si[:, :, 0, :, None] * PEER_N_KEYS + si[:, :, 1, None, :]
        best, pos = lax.top_k(cand.reshape(C, PEER_HEADS, PEER_TOPK * PEER_TOPK), PEER_TOPK)
        ids = jnp.take_along_axis(cand_id.reshape(C, PEER_HEADS, PEER_TOPK * PEER_TOPK), pos, axis=-1)
        g = jax.nn.softmax(best, axis=-1)
        ue = jnp.take(u, ids, axis=0)
        ve = jnp.take(v, ids, axis=0)
        a = jax.nn.gelu(jnp.einsum('cd,chkd->chk', xc, ue), approximate=False)
        return jnp.einsum('chk,chkd->cd', (g * a).astype(xc.dtype), ve)

    return lax.map(one, xs).reshape(B, S, D)


def setup_inputs(seed: int = 0) -> dict:
    key = jax.random.key(seed)
    ks = jax.random.split(key, 24)
    D = D_MODEL
    nrm = lambda k, shape, s: jax.random.normal(k, shape, jnp.float32) * s
    return {
        "x": nrm(ks[0], (BATCH, SEQ, D), 1.0),
        "c": nrm(ks[1], (BATCH, D), 1.0),
        "ctx": nrm(ks[2], (BATCH, CTX_LEN, D), 1.0),
        "c_ctx": nrm(ks[3], (D,), 1.0),
        "w_mod": nrm(ks[4], (DEPTH, D, 6 * D), 0.5 * D ** -0.5),
        "b_mod": nrm(ks[5], (DEPTH, 6 * D), 0.01),
        "norm1_g": 1.0 + nrm(ks[6], (DEPTH, D), 0.02),
        "norm2_g": 1.0 + nrm(ks[7], (DEPTH, D), 0.02),
        "w_in": nrm(ks[8], (DEPTH, D, IN_COLS), D ** -0.5),
        "w_out": nrm(ks[9], (DEPTH, MIX_WIDTH, D), MIX_WIDTH ** -0.5),
        "diff_lq1": nrm(ks[10], (DEPTH, HEAD_DIM), 0.1),
        "diff_lk1": nrm(ks[11], (DEPTH, HEAD_DIM), 0.1),
        "diff_lq2": nrm(ks[12], (DEPTH, HEAD_DIM), 0.1),
        "diff_lk2": nrm(ks[13], (DEPTH, HEAD_DIM), 0.1),
        "diff_subln_g": 1.0 + nrm(ks[14], (DEPTH, DIFF_V_DIM), 0.02),
        "gqa_q_norm_g": 1.0 + nrm(ks[15], (DEPTH, HEAD_DIM), 0.02),
        "gqa_k_norm_g": 1.0 + nrm(ks[16], (DEPTH, HEAD_DIM), 0.02),
        "peer_wq": nrm(ks[17], (DEPTH, D, PEER_HEADS * PEER_QUERY_DIM), D ** -0.5),
        "peer_subkeys": nrm(ks[18], (DEPTH, PEER_HEADS, 2, PEER_N_KEYS, PEER_HALF), PEER_HALF ** -0.5),
        "peer_u": nrm(ks[19], (DEPTH, PEER_N_EXPERTS, D), D ** -0.5),
        "peer_v": nrm(ks[20], (DEPTH, PEER_N_EXPERTS, D), (PEER_HEADS * PEER_TOPK) ** -0.5),
        "final_norm_g": 1.0 + nrm(ks[21], (D,), 0.02),
    }


def reference(x, c, ctx, c_ctx, w_mod, b_mod, norm1_g, norm2_g, w_in, w_out,
              diff_lq1, diff_lk1, diff_lq2, diff_lk2, diff_subln_g,
              gqa_q_norm_g, gqa_k_norm_g, peer_wq, peer_subkeys, peer_u, peer_v,
              final_norm_g):
    for i in range(DEPTH):
        last = i == DEPTH - 1
        lambda_init = 0.8 - 0.6 * math.exp(-0.3 * i)
        mod_x = (jax.nn.silu(c) @ w_mod[i] + b_mod[i])[:, None, :]
        mod_c = jax.nn.silu(c_ctx) @ w_mod[i] + b_mod[i]
        sh1x, sc1x, g1x, sh2x, sc2x, g2x = jnp.split(mod_x, 6, axis=-1)
        sh1c, sc1c, g1c, sh2c, sc2c, g2c = jnp.split(mod_c, 6, axis=-1)

        hx = modulate(rmsnorm(x, norm1_g[i]), sh1x, sc1x)
        hc = modulate(rmsnorm(ctx, norm1_g[i]), sh1c, sc1c)
        c_dq, c_dk, c_dv, c_gq, c_gk, c_gv = _mixer_heads(hc @ w_in[i])
        x_dq, x_dk, x_dv, x_gq, x_gk, x_gv = _mixer_heads(hx @ w_in[i])
        c_gq = rmsnorm(c_gq, gqa_q_norm_g[i])
        c_gk = rmsnorm(c_gk, gqa_k_norm_g[i])
        x_gq = rope2d(rmsnorm(x_gq, gqa_q_norm_g[i]))
        x_gk = rope2d(rmsnorm(x_gk, gqa_k_norm_g[i]))
        x_dq = rope2d(x_dq)
        x_dk = rope2d(x_dk)
        lam = (jnp.exp(jnp.sum(diff_lq1[i].astype(jnp.float32) * diff_lk1[i].astype(jnp.float32)))
               - jnp.exp(jnp.sum(diff_lq2[i].astype(jnp.float32) * diff_lk2[i].astype(jnp.float32)))
               + lambda_init)
        out_x = _mix_queries(x_dq, x_gq,
                             jnp.concatenate([c_dk, x_dk], axis=1),
                             jnp.concatenate([c_dv, x_dv], axis=1),
                             jnp.concatenate([c_gk, x_gk], axis=1),
                             jnp.concatenate([c_gv, x_gv], axis=1),
                             lam, lambda_init, diff_subln_g[i], w_out[i])
        if not last:
            out_c = _mix_queries(c_dq, c_gq, c_dk, c_dv, c_gk, c_gv,
                                 lam, lambda_init, diff_subln_g[i], w_out[i])
            ctx = ctx + g1c * out_c
        x = x + g1x * out_x

        hx2 = modulate(rmsnorm(x, norm2_g[i]), sh2x, sc2x)
        x = x + g2x * peer(hx2, peer_wq[i], peer_subkeys[i], peer_u[i], peer_v[i])
        if not last:
            hc2 = modulate(rmsnorm(ctx, norm2_g[i]), sh2c, sc2c)
            ctx = ctx + g2c * peer(hc2, peer_wq[i], peer_subkeys[i], peer_u[i], peer_v[i])
    return rmsnorm(x, final_norm_g)
```

```cpp
#include <hip/hip_runtime.h>
#include <hip/hip_cooperative_groups.h>
#include <cstdio>
namespace cg = cooperative_groups;

typedef __attribute__((ext_vector_type(8))) short bf16x8;
typedef __attribute__((ext_vector_type(16))) float f32x16;
#define DI __device__ __forceinline__
#define MFMA(a, b, c) __builtin_amdgcn_mfma_f32_32x32x16_bf16((a), (b), (c), 0, 0, 0)

#define NB 8
#define SEQ 4096
#define CTX 256
#define LK 4352
#define DM 1024
#define NROWS_ALL 34816
#define NROWS_X 32768
#define INC 2304
#define EPS 1e-6f

#define WS_MOD   0ull
#define WS_ROPE  (WS_MOD + 221184ull)
#define WS_LAM   (WS_ROPE + 8192ull)
#define WS_WIN   (WS_LAM + 256ull)
#define WS_WOUT  (WS_WIN + 4718592ull)
#define WS_WQ    (WS_WOUT + 2097152ull)
#define WS_SK    (WS_WQ + 4194304ull)
#define WS_U     (WS_SK + 524288ull)
#define WS_V     (WS_U + 33554432ull)
#define WS_HN    (WS_V + 33554432ull)
#define WS_QD    (WS_HN + 71303168ull)
#define WS_QG    (WS_QD + 33554432ull)
#define WS_KD    (WS_QG + 33554432ull)
#define WS_KG    (WS_KD + 35651584ull)
#define WS_VDT   (WS_KG + 8912896ull)
#define WS_VGT   (WS_VDT + 35651584ull)
#define WS_OMIX  (WS_VGT + 8912896ull)
#define WS_END   (WS_OMIX + 67108864ull)

struct Params {
  const float *x, *c, *ctx, *c_ctx, *w_mod, *b_mod, *n1g, *n2g, *w_in, *w_out;
  const float *lq1, *lk1, *lq2, *lk2, *subln, *gqn, *gkn, *wq, *sk, *u, *v, *fng;
  float* out;
  char* ws;
};

DI unsigned f2bf(float x) { unsigned u = __float_as_uint(x); u += 0x7fffu + ((u >> 16) & 1u); return u >> 16; }
DI unsigned pack2(float lo, float hi) { return f2bf(lo) | (f2bf(hi) << 16); }
DI float bflo(unsigned p) { return __uint_as_float(p << 16); }
DI float bfhi(unsigned p) { return __uint_as_float(p & 0xffff0000u); }
DI int crow(int i, int h) { return (i & 3) + 8 * (i >> 2) + 4 * h; }
DI float wave_sum(float v) {
#pragma unroll
  for (int o = 32; o > 0; o >>= 1) v += __shfl_xor(v, o);
  return v;
}
DI bf16x8 pack8(float a0, float a1, float a2, float a3, float a4, float a5, float a6, float a7) {
  uint4 p; p.x = pack2(a0, a1); p.y = pack2(a2, a3); p.z = pack2(a4, a5); p.w = pack2(a6, a7);
  return __builtin_bit_cast(bf16x8, p);
}

#define GLD 72
DI void gemm_mainloop(const short* __restrict__ gA, const short* __restrict__ gB, short* lds, f32x16 (&acc)[2][2]) {
  const int tid = threadIdx.x, lane = tid & 63, wave = tid >> 6, wa = wave >> 1, wb = wave & 1;
  short* sA = lds; short* sB = lds + 2 * 128 * GLD;
  const int lrow = tid >> 3, lch = tid & 7;
  uint4 ra[4], rb[4];
#pragma unroll
  for (int i = 0; i < 2; ++i)
#pragma unroll
    for (int j = 0; j < 2; ++j)
#pragma unroll
      for (int r = 0; r < 16; ++r) acc[i][j][r] = 0.f;
  const short* pA = gA + (size_t)lrow * DM + lch * 8;
  const short* pB = gB + (size_t)lrow * DM + lch * 8;
#pragma unroll
  for (int r = 0; r < 4; ++r) { ra[r] = *(const uint4*)(pA + (size_t)r * 32 * DM); rb[r] = *(const uint4*)(pB + (size_t)r * 32 * DM); }
#pragma unroll
  for (int r = 0; r < 4; ++r) { *(uint4*)(sA + (lrow + 32 * r) * GLD + lch * 8) = ra[r]; *(uint4*)(sB + (lrow + 32 * r) * GLD + lch * 8) = rb[r]; }
  __syncthreads();
  const int fr = lane & 31, h = lane >> 5;
  for (int kt = 0; kt < 16; ++kt) {
    const int buf = kt & 1;
    if (kt < 15) {
      const int k0 = (kt + 1) * 64;
#pragma unroll
      for (int r = 0; r < 4; ++r) { ra[r] = *(const uint4*)(pA + (size_t)r * 32 * DM + k0); rb[r] = *(const uint4*)(pB + (size_t)r * 32 * DM + k0); }
    }
    const short* fa = sA + buf * 128 * GLD + (64 * wa + fr) * GLD + h * 8;
    const short* fb = sB + buf * 128 * GLD + (64 * wb + fr) * GLD + h * 8;
#pragma unroll
    for (int s = 0; s < 4; ++s) {
      bf16x8 a0 = *(const bf16x8*)(fa + s * 16), a1 = *(const bf16x8*)(fa + 32 * GLD + s * 16);
      bf16x8 b0 = *(const bf16x8*)(fb + s * 16), b1 = *(const bf16x8*)(fb + 32 * GLD + s * 16);
      acc[0][0] = MFMA(a0, b0, acc[0][0]); acc[0][1] = MFMA(a0, b1, acc[0][1]);
      acc[1][0] = MFMA(a1, b0, acc[1][0]); acc[1][1] = MFMA(a1, b1, acc[1][1]);
    }
    if (kt < 15) {
      short* dA = sA + (buf ^ 1) * 128 * GLD; short* dB = sB + (buf ^ 1) * 128 * GLD;
#pragma unroll
      for (int r = 0; r < 4; ++r) { *(uint4*)(dA + (lrow + 32 * r) * GLD + lch * 8) = ra[r]; *(uint4*)(dB + (lrow + 32 * r) * GLD + lch * 8) = rb[r]; }
    }
    __syncthreads();
  }
}

#define P0_MOD 192
#define P0_TR  1344
#define P0_CV  4128
#define P0_ITEMS (P0_MOD + P0_TR + P0_CV + 1)
DI float silu(float v) { return v / (1.f + __expf(-v)); }

DI void phase0(const Params& p, float* ldsf) {
  const int tid = threadIdx.x;
  for (int it = blockIdx.x; it < P0_ITEMS; it += gridDim.x) {
    if (it < P0_MOD) {
      for (int e = tid; e < 9 * 1024; e += 256) { float v = e < 8192 ? p.c[e] : p.c_ctx[e - 8192]; ldsf[e] = silu(v); }
      __syncthreads();
      const int col = tid & 31, kg = tid >> 5, n = it * 32 + col;
      float a[9];
#pragma unroll
      for (int r = 0; r < 9; ++r) a[r] = 0.f;
      for (int k = kg * 128; k < kg * 128 + 128; ++k) {
        float w = p.w_mod[(size_t)k * 6144 + n];
#pragma unroll
        for (int r = 0; r < 9; ++r) a[r] += ldsf[r * 1024 + k] * w;
      }
      float* red = ldsf + 9216;
#pragma unroll
      for (int r = 0; r < 9; ++r) red[(kg * 9 + r) * 32 + col] = a[r];
      __syncthreads();
      for (int idx = tid; idx < 288; idx += 256) {
        const int r = idx >> 5, cc = idx & 31; float s = 0.f;
#pragma unroll
        for (int g = 0; g < 8; ++g) s += red[(g * 9 + r) * 32 + cc];
        ((float*)(p.ws + WS_MOD))[r * 6144 + it * 32 + cc] = s + p.b_mod[it * 32 + cc];
      }
      __syncthreads();
    } else if (it < P0_MOD + P0_TR) {
      int t = it - P0_MOD; const float* src; unsigned short* dst; int N, nt_cnt;
      if (t < 576) { src = p.w_in; dst = (unsigned short*)(p.ws + WS_WIN); N = 2304; nt_cnt = 36; }
      else if (t < 832) { t -= 576; src = p.w_out; dst = (unsigned short*)(p.ws + WS_WOUT); N = 1024; nt_cnt = 16; }
      else { t -= 832; src = p.wq; dst = (unsigned short*)(p.ws + WS_WQ); N = 2048; nt_cnt = 32; }
      const int kt = t / nt_cnt, nt = t % nt_cnt;
      const int cc = tid & 63, r0 = tid >> 6;
#pragma unroll
      for (int j = 0; j < 16; ++j) { int r = r0 + 4 * j; ldsf[r * 65 + cc] = src[(size_t)(kt * 64 + r) * N + nt * 64 + cc]; }
      __syncthreads();
#pragma unroll
      for (int j = 0; j < 16; ++j) { int n = r0 + 4 * j; dst[(size_t)(nt * 64 + n) * 1024 + kt * 64 + cc] = (unsigned short)f2bf(ldsf[cc * 65 + n]); }
      __syncthreads();
    } else if (it < P0_MOD + P0_TR + P0_CV) {
      int t = it - P0_MOD - P0_TR; const float* src; char* dst;
      if (t < 32) { src = p.sk; dst = p.ws + WS_SK; }
      else if (t < 32 + 2048) { t -= 32; src = p.u; dst = p.ws + WS_U; }
      else { t -= 2080; src = p.v; dst = p.ws + WS_V; }
#pragma unroll
      for (int j = 0; j < 4; ++j) {
        size_t idx = (size_t)t * 8192 + j * 2048 + tid * 8;
        float4 a = *(const float4*)(src + idx), b = *(const float4*)(src + idx + 4);
        uint4 o; o.x = pack2(a.x, a.y); o.y = pack2(a.z, a.w); o.z = pack2(b.x, b.y); o.w = pack2(b.z, b.w);
        *(uint4*)(dst + idx * 2) = o;
      }
    } else {
      float2* rt = (float2*)(p.ws + WS_ROPE);
      for (int e = tid; e < 1024; e += 256) {
        const int pos = e >> 4, fi = e & 15;
        float freq = powf(10000.f, -(float)fi / 16.f);
        float ang = (float)pos * freq;
        rt[e] = make_float2(cosf(ang), sinf(ang));
      }
      if (tid == 0) {
        float s1 = 0.f, s2 = 0.f;
        for (int i = 0; i < 64; ++i) { s1 += p.lq1[i] * p.lk1[i]; s2 += p.lq2[i] * p.lk2[i]; }
        *(float*)(p.ws + WS_LAM) = expf(s1) - expf(s2) + 0.2f;
      }
    }
  }
}

DI void prep_row(const float* __restrict__ src, const float* __restrict__ g, const float* __restrict__ sh, const float* __restrict__ sc, short* __restrict__ dst) {
  const int lane = threadIdx.x & 63;
  float4 v[4]; float ss = 0.f;
#pragma unroll
  for (int j = 0; j < 4; ++j) { v[j] = *(const float4*)(src + 4 * (lane + 64 * j)); ss += v[j].x * v[j].x + v[j].y * v[j].y + v[j].z * v[j].z + v[j].w * v[j].w; }
  ss = wave_sum(ss);
  const float rinv = rsqrtf(ss * (1.f / 1024.f) + EPS);
#pragma unroll
  for (int j = 0; j < 4; ++j) {
    const int d = 4 * (lane + 64 * j);
    float4 gg = *(const float4*)(g + d), s1 = *(const float4*)(sc + d), s0 = *(const float4*)(sh + d);
    float y0 = v[j].x * rinv * gg.x * (1.f + s1.x) + s0.x;
    float y1 = v[j].y * rinv * gg.y * (1.f + s1.y) + s0.y;
    float y2 = v[j].z * rinv * gg.z * (1.f + s1.z) + s0.z;
    float y3 = v[j].w * rinv * gg.w * (1.f + s1.w) + s0.w;
    uint2 o; o.x = pack2(y0, y1); o.y = pack2(y2, y3);
    *(uint2*)(dst + d) = o;
  }
}
DI void phase1(const Params& p) {
  const int wave = threadIdx.x >> 6;
  const float* mod = (const float*)(p.ws + WS_MOD);
  for (int g = blockIdx.x; g < NROWS_ALL / 4; g += gridDim.x) {
    const int r = g * 4 + wave, b = r / LK, t = r % LK;
    const float* src = t < CTX ? p.ctx + ((size_t)b * CTX + t) * DM : p.x + ((size_t)b * SEQ + t - CTX) * DM;
    const float* m = mod + (t < CTX ? 8 : b) * 6144;
    prep_row(src, p.n1g, m, m + 1024, (short*)(p.ws + WS_HN) + (size_t)r * DM);
  }
}
DI void phase5(const Params& p) {
  const int wave = threadIdx.x >> 6;
  const float* mod = (const float*)(p.ws + WS_MOD);
  for (int g = blockIdx.x; g < NROWS_X / 4; g += gridDim.x) {
    const int r = g * 4 + wave, b = r / SEQ;
    const float* m = mod + b * 6144;
    prep_row(p.out + (size_t)r * DM, p.n2g, m + 3072, m + 4096, (short*)(p.ws + WS_HN) + (size_t)r * DM);
  }
}

DI void phase2(const Params& p, short* lds) {
  const int tid = threadIdx.x, lane = tid & 63, wave = tid >> 6, wa = wave >> 1, wb = wave & 1, fr = lane & 31, h = lane >> 5;
  const short* HN = (const short*)(p.ws + WS_HN);
  const short* WIN = (const short*)(p.ws + WS_WIN);
  const float2* rope = (const float2*)(p.ws + WS_ROPE);
  for (int tile = blockIdx.x; tile < 272 * 18; tile += gridDim.x) {
    const int ct = tile % 18, rt = tile / 18;
    const int b = rt / 34, trow = (rt % 34) * 128;
    const bool isctx = trow < CTX;
    const bool qtype = (ct < 4) || (ct >= 12 && ct < 16);
    if (isctx && qtype) continue;
    const bool vtype = (ct >= 8 && ct < 12) || ct == 17;
    f32x16 acc[2][2];
    const short* gTok = HN + (size_t)rt * 128 * DM;
    const short* gW = WIN + (size_t)ct * 128 * DM;
    if (vtype) {
      gemm_mainloop(gTok, gW, lds, acc);
#pragma unroll
      for (int tb = 0; tb < 2; ++tb) {
        short* rowp;
        if (ct == 17) rowp = (short*)(p.ws + WS_VGT) + ((size_t)(b * 2 + wb) * 64 + 32 * tb + fr) * LK;
        else rowp = (short*)(p.ws + WS_VDT) + ((size_t)(b * 4 + (ct - 8)) * 128 + 64 * wb + 32 * tb + fr) * LK;
#pragma unroll
        for (int ta = 0; ta < 2; ++ta)
#pragma unroll
          for (int A = 0; A < 2; ++A) {
            const int pos = trow + 64 * wa + 32 * ta + 16 * A + 8 * h;
            const f32x16& c = acc[ta][tb];
            *(bf16x8*)(rowp + pos) = pack8(c[8 * A], c[8 * A + 1], c[8 * A + 2], c[8 * A + 3], c[8 * A + 4], c[8 * A + 5], c[8 * A + 6], c[8 * A + 7]);
          }
      }
    } else {
      gemm_mainloop(gW, gTok, lds, acc);
      const bool norm = ct >= 12;
      const float* gn = (ct == 16) ? p.gkn : p.gqn;
      short* dst; int rows_per;
      bool use_s;
      if (ct < 4)       { dst = (short*)(p.ws + WS_QD) + (size_t)(b * 8 + ct * 2 + wa) * SEQ * 64; use_s = true; }
      else if (ct < 8)  { dst = (short*)(p.ws + WS_KD) + (size_t)(b * 8 + (ct - 4) * 2 + wa) * LK * 64; use_s = false; }
      else if (ct < 16) { dst = (short*)(p.ws + WS_QG) + (size_t)(b * 8 + (ct - 12) * 2 + wa) * SEQ * 64; use_s = true; }
      else              { dst = (short*)(p.ws + WS_KG) + (size_t)(b * 2 + wa) * LK * 64; use_s = false; }
      (void)rows_per;
#pragma unroll
      for (int tb = 0; tb < 2; ++tb) {
        const int t = trow + 64 * wb + 32 * tb + fr;
        const int s = t - CTX;
        float v[2][16];
#pragma unroll
        for (int ta = 0; ta < 2; ++ta)
#pragma unroll
          for (int i = 0; i < 16; ++i) v[ta][i] = acc[ta][tb][i];
        if (norm) {
          float ss = 0.f;
#pragma unroll
          for (int ta = 0; ta < 2; ++ta)
#pragma unroll
            for (int i = 0; i < 16; ++i) ss += v[ta][i] * v[ta][i];
          ss += __shfl_xor(ss, 32);
          const float rinv = rsqrtf(ss * (1.f / 64.f) + EPS);
#pragma unroll
          for (int ta = 0; ta < 2; ++ta)
#pragma unroll
            for (int i = 0; i < 16; ++i) v[ta][i] *= rinv * gn[32 * ta + crow(i, h)];
        }
        if (!isctx) {
          const int pr = s >> 6, pc = s & 63;
#pragma unroll
          for (int ta = 0; ta < 2; ++ta) {
            const int pos = ta ? pc : pr;
#pragma unroll
            for (int i = 0; i < 8; ++i) {
              const float2 cs = rope[pos * 16 + crow(i, h)];
              const float x1 = v[ta][i], x2 = v[ta][i + 8];
              v[ta][i] = x1 * cs.x - x2 * cs.y;
              v[ta][i + 8] = x1 * cs.y + x2 * cs.x;
            }
          }
        }
        short* rowp = dst + (size_t)(use_s ? s : t) * 64;
#pragma unroll
        for (int ta = 0; ta < 2; ++ta)
#pragma unroll
          for (int g = 0; g < 4; ++g) {
            uint2 o; o.x = pack2(v[ta][4 * g], v[ta][4 * g + 1]); o.y = pack2(v[ta][4 * g + 2], v[ta][4 * g + 3]);
            *(uint2*)(rowp + 32 * ta + 8 * g + 4 * h) = o;
          }
      }
    }
  }
}

#define ALD 72
#define SM_C 0.18033688011112042f
#define SM_THR 8.0f
template <int DV>
DI void attn_run(const short* __restrict__ Qp, const short* __restrict__ Kp, const short* __restrict__ Vtp, short* lds, f32x16 (&O)[DV / 32]) {
  constexpr int NDV = DV / 32;
  constexpr int BUFSZ = (64 + 128) * ALD;
  const int tid = threadIdx.x, lane = tid & 63, wave = tid >> 6, fr = lane & 31, h = lane >> 5;
  bf16x8 qf[4];
#pragma unroll
  for (int s = 0; s < 4; ++s) qf[s] = *(const bf16x8*)(Qp + (size_t)(wave * 32 + fr) * 64 + s * 16 + h * 8);
#pragma unroll
  for (int d = 0; d < NDV; ++d)
#pragma unroll
    for (int i = 0; i < 16; ++i) O[d][i] = 0.f;
  float m = -1e30f, lsum = 0.f;
  const int lrow = tid >> 3, lch = tid & 7;
  uint4 kr[2], vr[NDV];
  const short* pK = Kp + (size_t)lrow * 64 + lch * 8;
  const short* pV = Vtp + (size_t)lrow * LK + lch * 8;
#pragma unroll
  for (int r = 0; r < 2; ++r) kr[r] = *(const uint4*)(pK + (size_t)r * 32 * 64);
#pragma unroll
  for (int r = 0; r < NDV; ++r) vr[r] = *(const uint4*)(pV + (size_t)r * 32 * LK);
#pragma unroll
  for (int r = 0; r < 2; ++r) *(uint4*)(lds + (lrow + 32 * r) * ALD + lch * 8) = kr[r];
#pragma unroll
  for (int r = 0; r < NDV; ++r) *(uint4*)(lds + 64 * ALD + (lrow + 32 * r) * ALD + lch * 8) = vr[r];
  __syncthreads();
  for (int kt = 0; kt < 68; ++kt) {
    const int buf = kt & 1;
    if (kt < 67) {
      const int k0 = (kt + 1) * 64;
#pragma unroll
      for (int r = 0; r < 2; ++r) kr[r] = *(const uint4*)(pK + (size_t)(k0 + r * 32) * 64);
#pragma unroll
      for (int r = 0; r < NDV; ++r) vr[r] = *(const uint4*)(pV + (size_t)r * 32 * LK + k0);
    }
    const short* sK = lds + buf * BUFSZ;
    const short* sV = sK + 64 * ALD;
    f32x16 S[2];
#pragma unroll
    for (int j = 0; j < 2; ++j) {
#pragma unroll
      for (int i = 0; i < 16; ++i) S[j][i] = 0.f;
#pragma unroll
      for (int s = 0; s < 4; ++s) {
        bf16x8 kf = *(const bf16x8*)(sK + (32 * j + fr) * ALD + s * 16 + h * 8);
        S[j] = MFMA(kf, qf[s], S[j]);
      }
    }
    float mx = S[0][0];
#pragma unroll
    for (int i = 1; i < 16; ++i) mx = fmaxf(mx, S[0][i]);
#pragma unroll
    for (int i = 0; i < 16; ++i) mx = fmaxf(mx, S[1][i]);
    mx = fmaxf(mx, __shfl_xor(mx, 32));
    const float mc = mx * SM_C;
    if (__any(mc > m + SM_THR)) {
      const float mn = fmaxf(m, mc);
      const float alpha = exp2f(m - mn);
      m = mn; lsum *= alpha;
#pragma unroll
      for (int d = 0; d < NDV; ++d)
#pragma unroll
        for (int i = 0; i < 16; ++i) O[d][i] *= alpha;
    }
#pragma unroll
    for (int j = 0; j < 2; ++j)
#pragma unroll
      for (int i = 0; i < 16; ++i) { float pv = exp2f(S[j][i] * SM_C - m); S[j][i] = pv; lsum += pv; }
    bf16x8 pf[2][2];
#pragma unroll
    for (int j = 0; j < 2; ++j)
#pragma unroll
      for (int s = 0; s < 2; ++s)
        pf[j][s] = pack8(S[j][8 * s], S[j][8 * s + 1], S[j][8 * s + 2], S[j][8 * s + 3], S[j][8 * s + 4], S[j][8 * s + 5], S[j][8 * s + 6], S[j][8 * s + 7]);
#pragma unroll
    for (int d = 0; d < NDV; ++d)
#pragma unroll
      for (int j = 0; j < 2; ++j)
#pragma unroll
        for (int s = 0; s < 2; ++s) {
          bf16x8 vf = *(const bf16x8*)(sV + (32 * d + fr) * ALD + 32 * j + 16 * s + 8 * h);
          O[d] = MFMA(vf, pf[j][s], O[d]);
        }
    if (kt < 67) {
      short* dK = lds + (buf ^ 1) * BUFSZ; short* dV = dK + 64 * ALD;
#pragma unroll
      for (int r = 0; r < 2; ++r) *(uint4*)(dK + (lrow + 32 * r) * ALD + lch * 8) = kr[r];
#pragma unroll
      for (int r = 0; r < NDV; ++r) *(uint4*)(dV + (lrow + 32 * r) * ALD + lch * 8) = vr[r];
    }
    __syncthreads();
  }
  lsum += __shfl_xor(lsum, 32);
  const float inv = 1.f / lsum;
#pragma unroll
  for (int d = 0; d < NDV; ++d)
#pragma unroll
    for (int i = 0; i < 16; ++i) O[d][i] *= inv;
}

DI void attn_diff_item(const Params& p, short* lds, int b, int hd, int qb) {
  const int lane = threadIdx.x & 63, wave = threadIdx.x >> 6, fr = lane & 31, h = lane >> 5;
  const short* Vt = (const short*)(p.ws + WS_VDT) + (size_t)(b * 4 + hd) * 128 * LK;
  unsigned o1p[32];
  {
    f32x16 O[4];
    attn_run<128>((const short*)(p.ws + WS_QD) + ((size_t)(b * 8 + hd * 2) * SEQ + qb * 128) * 64,
                  (const short*)(p.ws + WS_KD) + (size_t)(b * 8 + hd * 2) * LK * 64, Vt, lds, O);
#pragma unroll
    for (int d = 0; d < 4; ++d)
#pragma unroll
      for (int i = 0; i < 8; ++i) o1p[d * 8 + i] = pack2(O[d][2 * i], O[d][2 * i + 1]);
  }
  f32x16 O[4];
  attn_run<128>((const short*)(p.ws + WS_QD) + ((size_t)(b * 8 + hd * 2 + 1) * SEQ + qb * 128) * 64,
                (const short*)(p.ws + WS_KD) + (size_t)(b * 8 + hd * 2 + 1) * LK * 64, Vt, lds, O);
  const float lam = *(const float*)(p.ws + WS_LAM);
  float ss = 0.f;
#pragma unroll
  for (int d = 0; d < 4; ++d)
#pragma unroll
    for (int i = 0; i < 8; ++i) {
      float a = bflo(o1p[d * 8 + i]) - lam * O[d][2 * i];
      float c = bfhi(o1p[d * 8 + i]) - lam * O[d][2 * i + 1];
      O[d][2 * i] = a; O[d][2 * i + 1] = c; ss += a * a + c * c;
    }
  ss += __shfl_xor(ss, 32);
  const float rinv = rsqrtf(ss * (1.f / 128.f) + EPS) * 0.8f;
  short* rowp = (short*)(p.ws + WS_OMIX) + ((size_t)b * SEQ + qb * 128 + wave * 32 + fr) * DM + hd * 128;
#pragma unroll
  for (int d = 0; d < 4; ++d)
#pragma unroll
    for (int g = 0; g < 4; ++g) {
      const int dv = 32 * d + 8 * g + 4 * h;
      const float4 sg = *(const float4*)(p.subln + dv);
      uint2 o; o.x = pack2(O[d][4 * g] * rinv * sg.x, O[d][4 * g + 1] * rinv * sg.y);
      o.y = pack2(O[d][4 * g + 2] * rinv * sg.z, O[d][4 * g + 3] * rinv * sg.w);
      *(uint2*)(rowp + dv) = o;
    }
}
DI void attn_gqa_item(const Params& p, short* lds, int b, int qh, int qb) {
  const int lane = threadIdx.x & 63, wave = threadIdx.x >> 6, fr = lane & 31, h = lane >> 5;
  const int kvh = qh >> 2;
  f32x16 O[2];
  attn_run<64>((const short*)(p.ws + WS_QG) + ((size_t)(b * 8 + qh) * SEQ + qb * 128) * 64,
               (const short*)(p.ws + WS_KG) + (size_t)(b * 2 + kvh) * LK * 64,
               (const short*)(p.ws + WS_VGT) + (size_t)(b * 2 + kvh) * 64 * LK, lds, O);
  short* rowp = (short*)(p.ws + WS_OMIX) + ((size_t)b * SEQ + qb * 128 + wave * 32 + fr) * DM + 512 + qh * 64;
#pragma unroll
  for (int d = 0; d < 2; ++d)
#pragma unroll
    for (int g = 0; g < 4; ++g) {
      uint2 o; o.x = pack2(O[d][4 * g], O[d][4 * g + 1]); o.y = pack2(O[d][4 * g + 2], O[d][4 * g + 3]);

#ifdef EXP_NOGQA
      o.x = 0; o.y = 0;
#endif
      *(uint2*)(rowp + 32 * d + 8 * g + 4 * h) = o;
    }
}
DI void phase3(const Params& p, short* lds) {
  const int xcd = blockIdx.x & 7, slot = blockIdx.x >> 3, nslots = gridDim.x >> 3;
  for (int j = slot; j < 128; j += nslots) {
    const int grp = xcd * 4 + (j >> 5);
    attn_diff_item(p, lds, grp >> 2, grp & 3, j & 31);
  }
  for (int j = slot; j < 256; j += nslots) {
    const int sg = xcd * 2 + (j >> 7);
    attn_gqa_item(p, lds, sg >> 1, (sg & 1) * 4 + ((j & 127) >> 5), j & 31);
  }
}

DI void phase4(const Params& p, short* lds) {
  const int tid = threadIdx.x, lane = tid & 63, wave = tid >> 6, wa = wave >> 1, wb = wave & 1, fr = lane & 31, h = lane >> 5;
  const float* mod = (const float*)(p.ws + WS_MOD);
  for (int tile = blockIdx.x; tile < 256 * 8; tile += gridDim.x) {
    const int ct = tile & 7, rt = tile >> 3;
    f32x16 acc[2][2];
    gemm_mainloop((const short*)(p.ws + WS_OMIX) + (size_t)rt * 128 * DM, (const short*)(p.ws + WS_WOUT) + (size_t)ct * 128 * DM, lds, acc);
    const int b = rt >> 5;
#pragma unroll
    for (int tb = 0; tb < 2; ++tb) {
      const int n = ct * 128 + 64 * wb + 32 * tb + fr;
      const float g1 = mod[b * 6144 + 2048 + n];
#pragma unroll
      for (int ta = 0; ta < 2; ++ta)
#pragma unroll
        for (int i = 0; i < 16; ++i) {
          const size_t row = (size_t)rt * 128 + 64 * wa + 32 * ta + crow(i, h);
          p.out[row * DM + n] = p.x[row * DM + n] + g1 * acc[ta][tb][i];
        }
    }
  }
}

DI void cex(int& a, int& b, bool desc) { int mx = max(a, b), mn = min(a, b); a = desc ? mx : mn; b = desc ? mn : mx; }
DI void merge16(int (&a)[16], bool desc) {
#pragma unroll
  for (int j = 8; j > 0; j >>= 1)
#pragma unroll
    for (int i = 0; i < 16; ++i) { const int l = i ^ j; if (l > i) cex(a[i], a[l], desc); }
}
#define QLD 136
DI void phase6(const Params& p, short* lds) {
  const int tid = threadIdx.x, lane = tid & 63, wave = tid >> 6, wa = wave >> 1, wb = wave & 1, fr = lane & 31, h = lane >> 5;
  short* sQ = lds; short* sK = lds + 128 * QLD;
  int* TK1 = (int*)(p.ws + WS_QD);
  for (int tile = blockIdx.x; tile < 256 * 16; tile += gridDim.x) {
    const int hp = tile & 15, rt = tile >> 4;
    {
      f32x16 acc[2][2];
      gemm_mainloop((const short*)(p.ws + WS_WQ) + (size_t)hp * 128 * DM, (const short*)(p.ws + WS_HN) + (size_t)rt * 128 * DM, lds, acc);
#pragma unroll
      for (int tb = 0; tb < 2; ++tb)
#pragma unroll
        for (int ta = 0; ta < 2; ++ta)
#pragma unroll
          for (int g = 0; g < 4; ++g) {
            const f32x16& c = acc[ta][tb];
            uint2 o; o.x = pack2(c[4 * g], c[4 * g + 1]); o.y = pack2(c[4 * g + 2], c[4 * g + 3]);
            *(uint2*)(sQ + (64 * wb + 32 * tb + fr) * QLD + 64 * wa + 32 * ta + 8 * g + 4 * h) = o;
          }
    }
    {
      const short* skg = (const short*)(p.ws + WS_SK) + (size_t)hp * 128 * 128;
#pragma unroll
      for (int r = 0; r < 8; ++r) { const int c = tid + 256 * r; *(uint4*)(sK + (c >> 4) * QLD + (c & 15) * 8) = *(const uint4*)(skg + c * 8); }
    }
    __syncthreads();
    int v[64];
    {
      f32x16 sc[4];
#pragma unroll
      for (int k = 0; k < 4; ++k)
#pragma unroll
        for (int i = 0; i < 16; ++i) sc[k][i] = 0.f;
#pragma unroll
      for (int ks = 0; ks < 8; ++ks) {
        bf16x8 qf = *(const bf16x8*)(sQ + (32 * wave + fr) * QLD + ks * 16 + 8 * h);
#pragma unroll
        for (int k = 0; k < 4; ++k) {
          bf16x8 kf = *(const bf16x8*)(sK + (32 * k + fr) * QLD + ks * 16 + 8 * h);
          sc[k] = MFMA(kf, qf, sc[k]);
        }
      }
#pragma unroll
      for (int k = 0; k < 4; ++k)
#pragma unroll
        for (int i = 0; i < 16; ++i) {
          int key = __float_as_int(sc[k][i]); key ^= (key >> 31) & 0x7fffffff;
          v[16 * k + i] = (key & ~127) | (127 - (32 * k + crow(i, h)));
        }
    }
#pragma unroll
    for (int k = 2; k <= 16; k <<= 1)
#pragma unroll
      for (int j = k >> 1; j > 0; j >>= 1)
#pragma unroll
        for (int i = 0; i < 64; ++i) { const int l = i ^ j; if (l > i) cex(v[i], v[l], (i & k) != 0); }
    int a[16], bb[16];
#pragma unroll
    for (int i = 0; i < 16; ++i) { a[i] = max(v[i], v[16 + i]); bb[i] = max(v[32 + i], v[48 + i]); }
    merge16(a, false); merge16(bb, true);
#pragma unroll
    for (int i = 0; i < 16; ++i) a[i] = max(a[i], bb[i]);
    merge16(a, true);
#pragma unroll
    for (int i = 0; i < 16; ++i) bb[i] = __shfl_xor(a[i], 32);
#pragma unroll
    for (int i = 0; i < 16; ++i) a[i] = max(a[i], bb[15 - i]);
    merge16(a, true);
    {
      int* dst = TK1 + ((size_t)rt * 128 + 32 * wave + fr) * 256 + hp * 16 + 8 * h;
      int4 o0, o1;
      o0.x = h ? a[8] : a[0]; o0.y = h ? a[9] : a[1]; o0.z = h ? a[10] : a[2]; o0.w = h ? a[11] : a[3];
      o1.x = h ? a[12] : a[4]; o1.y = h ? a[13] : a[5]; o1.z = h ? a[14] : a[6]; o1.w = h ? a[15] : a[7];
      *(int4*)dst = o0; *(int4*)(dst + 4) = o1;
    }
    __syncthreads();
  }
}

DI float key2val(int k) { k &= ~127; k ^= (k >> 31) & 0x7fffffff; return __int_as_float(k); }
DI void phase7(const Params& p) {
  const int* TK1 = (const int*)(p.ws + WS_QD);
  int2* PE = (int2*)(p.ws + WS_QG);
  for (int blk = blockIdx.x; blk < NROWS_X * 8 / 256; blk += gridDim.x) {
    const int item = blk * 256 + threadIdx.x;
    const int4* src = (const int4*)(TK1 + (size_t)item * 32);
    int ka[16], kb[16];
#pragma unroll
    for (int q = 0; q < 4; ++q) { int4 t = src[q]; ka[4 * q] = t.x; ka[4 * q + 1] = t.y; ka[4 * q + 2] = t.z; ka[4 * q + 3] = t.w; }
#pragma unroll
    for (int q = 0; q < 4; ++q) { int4 t = src[4 + q]; kb[4 * q] = t.x; kb[4 * q + 1] = t.y; kb[4 * q + 2] = t.z; kb[4 * q + 3] = t.w; }
    float cv[50]; int cid[50];
    {
      int n = 0;
#pragma unroll
      for (int i = 0; i < 16; ++i)
#pragma unroll
        for (int j = 0; j < 16; ++j)
          if ((i + 1) * (j + 1) <= 16) {
            cv[n] = key2val(ka[i]) + key2val(kb[j]);
            cid[n] = (127 - (ka[i] & 127)) * 128 + (127 - (kb[j] & 127));
            ++n;
          }
    }
    float best[16]; int bid[16];
#pragma unroll
    for (int r = 0; r < 16; ++r) {
      float mv = cv[0]; int mi = cid[0];
#pragma unroll
      for (int c = 1; c < 50; ++c) if (cv[c] > mv) { mv = cv[c]; mi = cid[c]; }
      best[r] = mv; bid[r] = mi;
#pragma unroll
      for (int c = 0; c < 50; ++c) if (cid[c] == mi) cv[c] = -3.0e38f;
    }
    float sum = 0.f;
#pragma unroll
    for (int r = 15; r >= 0; --r) { best[r] = __expf(best[r] - best[0]); sum += best[r]; }
    const float inv = 1.f / sum;
    int4* dst = (int4*)(PE + (size_t)item * 16);
#pragma unroll
    for (int r = 0; r < 8; ++r) {
      int4 o; o.x = bid[2 * r]; o.y = __float_as_int(best[2 * r] * inv); o.z = bid[2 * r + 1]; o.w = __float_as_int(best[2 * r + 1] * inv);
      dst[r] = o;
    }
  }
}

DI float dot2bf(unsigned a, unsigned b, float acc) { return acc + bflo(a) * bflo(b) + bfhi(a) * bfhi(b); }
DI void phase8(const Params& p) {
  const int lane = threadIdx.x & 63, wave = threadIdx.x >> 6;
  const float* mod = (const float*)(p.ws + WS_MOD);
  const int2* PE = (const int2*)(p.ws + WS_QG);
  const short* U = (const short*)(p.ws + WS_U);
  const short* V = (const short*)(p.ws + WS_V);
  for (int g = blockIdx.x; g < NROWS_X / 4; g += gridDim.x) {
    const int tok = g * 4 + wave, b = tok / SEQ;
    const short* hrow = (const short*)(p.ws + WS_HN) + (size_t)tok * DM;
    const uint4 x0 = *(const uint4*)(hrow + 8 * lane), x1 = *(const uint4*)(hrow + 512 + 8 * lane);
    float o[16];
#pragma unroll
    for (int i = 0; i < 16; ++i) o[i] = 0.f;
#ifdef EXP_HALF0
    for (int half = 0; half < 1; ++half) {
#else
    for (int half = 0; half < 2; ++half) {
#endif
      const int2 mine = PE[(size_t)tok * 128 + half * 64 + lane];
      for (int e0 = 0; e0 < 64; e0 += 4) {
        int id[4]; float gt[4];
        uint4 ua[4], ub[4], va[4], vb[4];
#pragma unroll
        for (int k = 0; k < 4; ++k) {
          id[k] = __builtin_amdgcn_readlane(mine.x, e0 + k);
          gt[k] = __int_as_float(__builtin_amdgcn_readlane(mine.y, e0 + k));
          const short* ur = U + (size_t)id[k] * DM; const short* vr = V + (size_t)id[k] * DM;
          ua[k] = *(const uint4*)(ur + 8 * lane); ub[k] = *(const uint4*)(ur + 512 + 8 * lane);
          va[k] = *(const uint4*)(vr + 8 * lane); vb[k] = *(const uint4*)(vr + 512 + 8 * lane);
        }
#pragma unroll
        for (int k = 0; k < 4; ++k) {
          float d = 0.f;
          d = dot2bf(x0.x, ua[k].x, d); d = dot2bf(x0.y, ua[k].y, d); d = dot2bf(x0.z, ua[k].z, d); d = dot2bf(x0.w, ua[k].w, d);
          d = dot2bf(x1.x, ub[k].x, d); d = dot2bf(x1.y, ub[k].y, d); d = dot2bf(x1.z, ub[k].z, d); d = dot2bf(x1.w, ub[k].w, d);
          d = wave_sum(d);
          const float w = gt[k] * 0.5f * d * (1.f + erff(d * 0.70710678118654752f));
          o[0] += w * bflo(va[k].x); o[1] += w * bfhi(va[k].x); o[2] += w * bflo(va[k].y); o[3] += w * bfhi(va[k].y);
          o[4] += w * bflo(va[k].z); o[5] += w * bfhi(va[k].z); o[6] += w * bflo(va[k].w); o[7] += w * bfhi(va[k].w);
          o[8] += w * bflo(vb[k].x); o[9] += w * bfhi(vb[k].x); o[10] += w * bflo(vb[k].y); o[11] += w * bfhi(vb[k].y);
          o[12] += w * bflo(vb[k].z); o[13] += w * bfhi(vb[k].z); o[14] += w * bflo(vb[k].w); o[15] += w * bfhi(vb[k].w);
        }
      }
    }
#ifdef EXP_NOPEER
    for (int i = 0; i < 16; ++i) o[i] = 0.f;
#endif
    float* orow = p.out + (size_t)tok * DM;
    const float* g2 = mod + b * 6144 + 5120;
    float xf[16]; float ss = 0.f;
#pragma unroll
    for (int q = 0; q < 4; ++q) {
      const int d = (q >> 1) * 512 + 8 * lane + (q & 1) * 4;
      const float4 xm = *(const float4*)(orow + d), gg = *(const float4*)(g2 + d);
      xf[4 * q] = xm.x + gg.x * o[4 * q]; xf[4 * q + 1] = xm.y + gg.y * o[4 * q + 1];
      xf[4 * q + 2] = xm.z + gg.z * o[4 * q + 2]; xf[4 * q + 3] = xm.w + gg.w * o[4 * q + 3];
      ss += xf[4 * q] * xf[4 * q] + xf[4 * q + 1] * xf[4 * q + 1] + xf[4 * q + 2] * xf[4 * q + 2] + xf[4 * q + 3] * xf[4 * q + 3];
    }
    ss = wave_sum(ss);
    const float rinv = rsqrtf(ss * (1.f / 1024.f) + EPS);
#pragma unroll
    for (int q = 0; q < 4; ++q) {
      const int d = (q >> 1) * 512 + 8 * lane + (q & 1) * 4;
      const float4 fg = *(const float4*)(p.fng + d);
      float4 r; r.x = xf[4 * q] * rinv * fg.x; r.y = xf[4 * q + 1] * rinv * fg.y; r.z = xf[4 * q + 2] * rinv * fg.z; r.w = xf[4 * q + 3] * rinv * fg.w;
      *(float4*)(orow + d) = r;
    }
  }
}

#ifndef MINW
#define MINW 1
#endif
#define RUN_PHASE(N, CALL) if (ph_lo <= N && N <= ph_hi) { if (N > ph_lo) grid.sync(); CALL; }
__global__ void __launch_bounds__(256, MINW) fwd_kernel(Params p, int ph_lo, int ph_hi) {
  __shared__ __attribute__((aligned(16))) short lds[4 * 128 * GLD];
  cg::grid_group grid = cg::this_grid();
  RUN_PHASE(0, phase0(p, (float*)lds))
  RUN_PHASE(1, phase1(p))
  RUN_PHASE(2, phase2(p, lds))
  RUN_PHASE(3, phase3(p, lds))
  RUN_PHASE(4, phase4(p, lds))
  RUN_PHASE(5, phase5(p))
  RUN_PHASE(6, phase6(p, lds))
  RUN_PHASE(7, phase7(p))
  RUN_PHASE(8, phase8(p))
}

#ifndef N_LAUNCH_MODE
#define N_LAUNCH_MODE 1
#endif

extern "C" void kernel_launch(void* const* d_in, const int* in_sizes, int n_in, void* d_out, int out_size, void* d_ws, size_t ws_size, hipStream_t stream) {
  static int grid_blocks = 0;
  if (!grid_blocks) {
    int dev = 0, cus = 0, per_cu = 0;
    hipGetDevice(&dev);
    hipDeviceGetAttribute(&cus, hipDeviceAttributeMultiprocessorCount, dev);
    hipOccupancyMaxActiveBlocksPerMultiprocessor(&per_cu, fwd_kernel, 256, 0);
    if (per_cu > 2) per_cu = 2;
    if (per_cu < 1) per_cu = 1;
    grid_blocks = cus * per_cu;
  }
  Params p{};
  const float** f = (const float**)&p;
  for (int i = 0; i < 22; ++i) f[i] = (const float*)d_in[i];
  p.out = (float*)d_out;
  p.ws = (char*)d_ws;
#if N_LAUNCH_MODE
  for (int ph = 0; ph <= 8; ++ph) hipLaunchKernelGGL(fwd_kernel, dim3(grid_blocks), dim3(256), 0, stream, p, ph, ph);
#else
  int lo = 0, hi = 8;
  void* args[] = {&p, &lo, &hi};
  hipError_t e = hipLaunchCooperativeKernel((void*)fwd_kernel, dim3(grid_blocks), dim3(256), args, 0, stream);
  if (e != hipSuccess) fprintf(stderr, "cooperative launch failed: %s (grid %d)\n", hipGetErrorString(e), grid_blocks);
#endif
}
```

```cpp
#include <hip/hip_runtime.h>
#include <hip/hip_cooperative_groups.h>
#include <cstdio>
namespace cg = cooperative_groups;

typedef __attribute__((ext_vector_type(8))) short bf16x8;
typedef __attribute__((ext_vector_type(16))) float f32x16;
#define DI __device__ __forceinline__
#define MFMA(a, b, c) __builtin_amdgcn_mfma_f32_32x32x16_bf16((a), (b), (c), 0, 0, 0)

#define NB 8
#define SEQ 4096
#define CTX 256
#define LK 4352
#define DM 1024
#define NROWS_ALL 34816
#define NROWS_X 32768
#define INC 2304
#define EPS 1e-6f
#define NT 512
#define NW 8

#define WS_MOD   0ull
#define WS_ROPE  (WS_MOD + 221184ull)
#define WS_LAM   (WS_ROPE + 8192ull)
#define WS_WIN   (WS_LAM + 256ull)
#define WS_WOUT  (WS_WIN + 4718592ull)
#define WS_WQ    (WS_WOUT + 2097152ull)
#define WS_SK    (WS_WQ + 4194304ull)
#define WS_U     (WS_SK + 524288ull)
#define WS_V     (WS_U + 33554432ull)
#define WS_HN    (WS_V + 33554432ull)
#define WS_QD    (WS_HN + 71303168ull)
#define WS_QG    (WS_QD + 33554432ull)
#define WS_KD    (WS_QG + 33554432ull)
#define WS_KG    (WS_KD + 35651584ull)
#define WS_VDT   (WS_KG + 8912896ull)
#define WS_VGT   (WS_VDT + 35651584ull)
#define WS_OMIX  (WS_VGT + 8912896ull)
#define WS_END   (WS_OMIX + 67108864ull)
#define WS_SU    (WS_U + 16777216ull)
#define WS_SV    (WS_V + 16777216ull)
#define WS_IDS   WS_QG
#define WS_GW    (WS_QG + 8388608ull)
#define WS_PD    WS_KD
#define WS_PS    (WS_PD + 134217728ull)

struct Params {
  const float *x, *c, *ctx, *c_ctx, *w_mod, *b_mod, *n1g, *n2g, *w_in, *w_out;
  const float *lq1, *lk1, *lq2, *lk2, *subln, *gqn, *gkn, *wq, *sk, *u, *v, *fng;
  float* out;
  char* ws;
};

DI unsigned f2bf(float x) { unsigned u = __float_as_uint(x); u += 0x7fffu + ((u >> 16) & 1u); return u >> 16; }
typedef __attribute__((ext_vector_type(2))) __bf16 bf16x2_t;
typedef __attribute__((ext_vector_type(2))) float f32x2_t;
DI unsigned pack2(float lo, float hi) { f32x2_t v = {lo, hi}; bf16x2_t b = __builtin_convertvector(v, bf16x2_t); return __builtin_bit_cast(unsigned, b); }
DI float bflo(unsigned p) { return __uint_as_float(p << 16); }
DI float bfhi(unsigned p) { return __uint_as_float(p & 0xffff0000u); }
DI int crow(int i, int h) { return (i & 3) + 8 * (i >> 2) + 4 * h; }
DI float wave_sum(float v) {
#pragma unroll
  for (int o = 32; o > 0; o >>= 1) v += __shfl_xor(v, o);
  return v;
}
DI bf16x8 pack8(float a0, float a1, float a2, float a3, float a4, float a5, float a6, float a7) {
  uint4 p; p.x = pack2(a0, a1); p.y = pack2(a2, a3); p.z = pack2(a4, a5); p.w = pack2(a6, a7);
  return __builtin_bit_cast(bf16x8, p);
}

#define GLD 72
DI void gemm_mainloop(const short* __restrict__ gA, const short* __restrict__ gB, short* lds, f32x16 (&acc)[2][2]) {
  const int tid = threadIdx.x, lane = tid & 63, wave = tid >> 6, wa = wave >> 1, wb = wave & 1;
  short* sA = lds; short* sB = lds + 2 * 128 * GLD;
  const int lrow = tid >> 3, lch = tid & 7;
  uint4 ra0, ra1, ra2, ra3, rb0, rb1, rb2, rb3;
#pragma unroll
  for (int i = 0; i < 2; ++i)
#pragma unroll
    for (int j = 0; j < 2; ++j)
#pragma unroll
      for (int r = 0; r < 16; ++r) acc[i][j][r] = 0.f;
  const short* pA = gA + (size_t)lrow * DM + lch * 8;
  const short* pB = gB + (size_t)lrow * DM + lch * 8;
#define G_LOAD(K0) { ra0 = *(const uint4*)(pA + (K0)); ra1 = *(const uint4*)(pA + (size_t)32 * DM + (K0)); ra2 = *(const uint4*)(pA + (size_t)64 * DM + (K0)); ra3 = *(const uint4*)(pA + (size_t)96 * DM + (K0)); \
                 rb0 = *(const uint4*)(pB + (K0)); rb1 = *(const uint4*)(pB + (size_t)32 * DM + (K0)); rb2 = *(const uint4*)(pB + (size_t)64 * DM + (K0)); rb3 = *(const uint4*)(pB + (size_t)96 * DM + (K0)); }
#define G_STORE(DA, DB) { short* da_ = (DA) + lrow * GLD + lch * 8; short* db_ = (DB) + lrow * GLD + lch * 8; \
                 *(uint4*)(da_) = ra0; *(uint4*)(da_ + 32 * GLD) = ra1; *(uint4*)(da_ + 64 * GLD) = ra2; *(uint4*)(da_ + 96 * GLD) = ra3; \
                 *(uint4*)(db_) = rb0; *(uint4*)(db_ + 32 * GLD) = rb1; *(uint4*)(db_ + 64 * GLD) = rb2; *(uint4*)(db_ + 96 * GLD) = rb3; }
  G_LOAD(0)
  G_STORE(sA, sB)
  __syncthreads();
  const int fr = lane & 31, h = lane >> 5;
  G_LOAD(64)
  for (int kt = 0; kt < 16; ++kt) {
    const int buf = kt & 1;
    const short* fa = sA + buf * 128 * GLD + (64 * wa + fr) * GLD + h * 8;
    const short* fb = sB + buf * 128 * GLD + (64 * wb + fr) * GLD + h * 8;
#pragma unroll
    for (int s = 0; s < 4; ++s) {
      bf16x8 a0 = *(const bf16x8*)(fa + s * 16), a1 = *(const bf16x8*)(fa + 32 * GLD + s * 16);
      bf16x8 b0 = *(const bf16x8*)(fb + s * 16), b1 = *(const bf16x8*)(fb + 32 * GLD + s * 16);
      acc[0][0] = MFMA(a0, b0, acc[0][0]); acc[0][1] = MFMA(a0, b1, acc[0][1]);
      acc[1][0] = MFMA(a1, b0, acc[1][0]); acc[1][1] = MFMA(a1, b1, acc[1][1]);
    }
    G_STORE(sA + (buf ^ 1) * 128 * GLD, sB + (buf ^ 1) * 128 * GLD)
    __syncthreads();
    const int k0 = (kt < 14 ? kt + 2 : 15) * 64;
    G_LOAD(k0)
  }
#undef G_LOAD
#undef G_STORE
}

DI void gemm_mainloop_d2(const short* __restrict__ gA, const short* __restrict__ gB, short* lds, f32x16 (&acc)[2][2]) {
  const int tid = threadIdx.x, lane = tid & 63, wave = tid >> 6, wa = wave >> 1, wb = wave & 1;
  short* sA = lds; short* sB = lds + 2 * 128 * GLD;
  const int lrow = tid >> 3, lch = tid & 7;
  uint4 xa0, xa1, xa2, xa3, xb0, xb1, xb2, xb3, ya0, ya1, ya2, ya3, yb0, yb1, yb2, yb3;
#pragma unroll
  for (int i = 0; i < 2; ++i)
#pragma unroll
    for (int j = 0; j < 2; ++j)
#pragma unroll
      for (int r = 0; r < 16; ++r) acc[i][j][r] = 0.f;
  const short* pA = gA + (size_t)lrow * DM + lch * 8;
  const short* pB = gB + (size_t)lrow * DM + lch * 8;
#define G_LOAD(P, K0) { P##a0 = *(const uint4*)(pA + (K0)); P##a1 = *(const uint4*)(pA + (size_t)32 * DM + (K0)); P##a2 = *(const uint4*)(pA + (size_t)64 * DM + (K0)); P##a3 = *(const uint4*)(pA + (size_t)96 * DM + (K0)); \
                 P##b0 = *(const uint4*)(pB + (K0)); P##b1 = *(const uint4*)(pB + (size_t)32 * DM + (K0)); P##b2 = *(const uint4*)(pB + (size_t)64 * DM + (K0)); P##b3 = *(const uint4*)(pB + (size_t)96 * DM + (K0)); }
#define G_STORE(P, DA, DB) { short* da_ = (DA) + lrow * GLD + lch * 8; short* db_ = (DB) + lrow * GLD + lch * 8; \
                 *(uint4*)(da_) = P##a0; *(uint4*)(da_ + 32 * GLD) = P##a1; *(uint4*)(da_ + 64 * GLD) = P##a2; *(uint4*)(da_ + 96 * GLD) = P##a3; \
                 *(uint4*)(db_) = P##b0; *(uint4*)(db_ + 32 * GLD) = P##b1; *(uint4*)(db_ + 64 * GLD) = P##b2; *(uint4*)(db_ + 96 * GLD) = P##b3; }
#define G_COMPUTE(BUF) { const short* fa = sA + (BUF) * 128 * GLD + (64 * wa + fr) * GLD + h * 8; const short* fb = sB + (BUF) * 128 * GLD + (64 * wb + fr) * GLD + h * 8; \
    _Pragma("unroll") for (int s = 0; s < 4; ++s) { \
      bf16x8 a0 = *(const bf16x8*)(fa + s * 16), a1 = *(const bf16x8*)(fa + 32 * GLD + s * 16); \
      bf16x8 b0 = *(const bf16x8*)(fb + s * 16), b1 = *(const bf16x8*)(fb + 32 * GLD + s * 16); \
      acc[0][0] = MFMA(a0, b0, acc[0][0]); acc[0][1] = MFMA(a0, b1, acc[0][1]); \
      acc[1][0] = MFMA(a1, b0, acc[1][0]); acc[1][1] = MFMA(a1, b1, acc[1][1]); } }
  G_LOAD(x, 0)
  G_STORE(x, sA, sB)
  __syncthreads();
  const int fr = lane & 31, h = lane >> 5;
  G_LOAD(x, 64)
  G_LOAD(y, 128)
  for (int kt = 0; kt < 16; kt += 2) {
    G_COMPUTE(0)
    G_STORE(x, sA + 128 * GLD, sB + 128 * GLD)
    __syncthreads();
    { const int k0 = (kt + 3 < 16 ? kt + 3 : 15) * 64; G_LOAD(x, k0) }
    G_COMPUTE(1)
    G_STORE(y, sA, sB)
    __syncthreads();
    { const int k0 = (kt + 4 < 16 ? kt + 4 : 15) * 64; G_LOAD(y, k0) }
  }
#undef G_LOAD
#undef G_STORE
#undef G_COMPUTE
}

template <int NWA, int NWB>
DI void gemm_ml8(const short* __restrict__ gA, const short* __restrict__ gB, short* lds, f32x16 (&acc)[2][2]) {
  constexpr int RA = 64 * NWA, STG = 384 * GLD;
  const int tid = threadIdx.x, lane = tid & 63, wave = tid >> 6, wa = wave / NWB, wb = wave % NWB;
  const int lrow = tid >> 3, lch = tid & 7;
  uint4 x0, x1, x2, x3, x4, x5, y0, y1, y2, y3, y4, y5;
#pragma unroll
  for (int i = 0; i < 2; ++i)
#pragma unroll
    for (int j = 0; j < 2; ++j)
#pragma unroll
      for (int r = 0; r < 16; ++r) acc[i][j][r] = 0.f;
#define GPTR(R) (((R) * 64 < RA) ? gA + (size_t)(lrow + (R) * 64) * DM + lch * 8 : gB + (size_t)(lrow + (R) * 64 - RA) * DM + lch * 8)
#define G_LOAD(P, K0) { P##0 = *(const uint4*)(GPTR(0) + (K0)); P##1 = *(const uint4*)(GPTR(1) + (K0)); P##2 = *(const uint4*)(GPTR(2) + (K0)); \
                 P##3 = *(const uint4*)(GPTR(3) + (K0)); P##4 = *(const uint4*)(GPTR(4) + (K0)); P##5 = *(const uint4*)(GPTR(5) + (K0)); }
#define G_STORE(P, BUF) { short* d_ = lds + (BUF) * STG + lrow * GLD + lch * 8; \
                 *(uint4*)(d_) = P##0; *(uint4*)(d_ + 64 * GLD) = P##1; *(uint4*)(d_ + 128 * GLD) = P##2; *(uint4*)(d_ + 192 * GLD) = P##3; *(uint4*)(d_ + 256 * GLD) = P##4; *(uint4*)(d_ + 320 * GLD) = P##5; }
#define G_COMPUTE(BUF) { const short* fa = lds + (BUF) * STG + (64 * wa + fr) * GLD + h * 8; const short* fb = lds + (BUF) * STG + (RA + 64 * wb + fr) * GLD + h * 8; \
    _Pragma("unroll") for (int s = 0; s < 4; ++s) { \
      bf16x8 a0 = *(const bf16x8*)(fa + s * 16), a1 = *(const bf16x8*)(fa + 32 * GLD + s * 16); \
      bf16x8 b0 = *(const bf16x8*)(fb + s * 16), b1 = *(const bf16x8*)(fb + 32 * GLD + s * 16); \
      acc[0][0] = MFMA(a0, b0, acc[0][0]); acc[0][1] = MFMA(a0, b1, acc[0][1]); \
      acc[1][0] = MFMA(a1, b0, acc[1][0]); acc[1][1] = MFMA(a1, b1, acc[1][1]); } }
  G_LOAD(x, 0)
  G_STORE(x, 0)
  __syncthreads();
  const int fr = lane & 31, h = lane >> 5;
  G_LOAD(x, 64)
  G_LOAD(y, 128)
  for (int kt = 0; kt < 16; kt += 2) {
    G_COMPUTE(0)
    G_STORE(x, 1)
    __syncthreads();
    { const int k0 = (kt + 3 < 16 ? kt + 3 : 15) * 64; G_LOAD(x, k0) }
    G_COMPUTE(1)
    G_STORE(y, 0)
    __syncthreads();
    { const int k0 = (kt + 4 < 16 ? kt + 4 : 15) * 64; G_LOAD(y, k0) }
  }
#undef GPTR
#undef G_LOAD
#undef G_STORE
#undef G_COMPUTE
}

#define P0_MOD 192
#define P0_TR  1344
#define P0_CV  (32 + 8192)
#define P0_ITEMS (P0_MOD + P0_TR + P0_CV + 1)
DI float silu(float v) { return v / (1.f + __expf(-v)); }

DI void phase0(const Params& p, float* ldsf) {
  const int tid = threadIdx.x & 255, sb = threadIdx.x >> 8;
  ldsf += sb * 11520;
  for (int it0 = 2 * blockIdx.x; it0 < P0_ITEMS; it0 += 2 * gridDim.x) {
    const int it = it0 + sb;
    if (it >= P0_ITEMS) continue;
    if (it < P0_MOD) {
      for (int e = tid; e < 9 * 1024; e += 256) { float v = e < 8192 ? p.c[e] : p.c_ctx[e - 8192]; ldsf[e] = silu(v); }
      __syncthreads();
      const int col = tid & 31, kg = tid >> 5, n = it * 32 + col;
      float a[9];
#pragma unroll
      for (int r = 0; r < 9; ++r) a[r] = 0.f;
      for (int k = kg * 128; k < kg * 128 + 128; k += 16) {
        float w[16];
#pragma unroll
        for (int u = 0; u < 16; ++u) w[u] = p.w_mod[(size_t)(k + u) * 6144 + n];
#pragma unroll
        for (int u = 0; u < 16; ++u)
#pragma unroll
          for (int r = 0; r < 9; ++r) a[r] += ldsf[r * 1024 + k + u] * w[u];
      }
      float* red = ldsf + 9216;
#pragma unroll
      for (int r = 0; r < 9; ++r) red[(kg * 9 + r) * 32 + col] = a[r];
      __syncthreads();
      for (int idx = tid; idx < 288; idx += 256) {
        const int r = idx >> 5, cc = idx & 31; float s = 0.f;
#pragma unroll
        for (int g = 0; g < 8; ++g) s += red[(g * 9 + r) * 32 + cc];
        ((float*)(p.ws + WS_MOD))[r * 6144 + it * 32 + cc] = s + p.b_mod[it * 32 + cc];
      }
      __syncthreads();
    } else if (it < P0_MOD + P0_TR) {
      int t = it - P0_MOD; const float* src; unsigned short* dst; int N, nt_cnt;
      if (t < 576) { src = p.w_in; dst = (unsigned short*)(p.ws + WS_WIN); N = 2304; nt_cnt = 36; }
      else if (t < 832) { t -= 576; src = p.w_out; dst = (unsigned short*)(p.ws + WS_WOUT); N = 1024; nt_cnt = 16; }
      else { t -= 832; src = p.wq; dst = (unsigned short*)(p.ws + WS_WQ); N = 2048; nt_cnt = 32; }
      const int kt = t / nt_cnt, nt = t % nt_cnt;
      const int cc = tid & 63, r0 = tid >> 6;
#pragma unroll
      for (int j = 0; j < 16; ++j) { int r = r0 + 4 * j; ldsf[r * 65 + cc] = src[(size_t)(kt * 64 + r) * N + nt * 64 + cc]; }
      __syncthreads();
#pragma unroll
      for (int j = 0; j < 16; ++j) { int n = r0 + 4 * j; dst[(size_t)(nt * 64 + n) * 1024 + kt * 64 + cc] = (unsigned short)f2bf(ldsf[cc * 65 + n]); }
      __syncthreads();
    } else if (it < P0_MOD + P0_TR + 32) {
      const int t = it - P0_MOD - P0_TR; const float* src = p.sk; char* dst = p.ws + WS_SK;
#pragma unroll
      for (int j = 0; j < 4; ++j) {
        size_t idx = (size_t)t * 8192 + j * 2048 + tid * 8;
        float4 a = *(const float4*)(src + idx), b = *(const float4*)(src + idx + 4);
        uint4 o; o.x = pack2(a.x, a.y); o.y = pack2(a.z, a.w); o.z = pack2(b.x, b.y); o.w = pack2(b.z, b.w);
        *(uint4*)(dst + idx * 2) = o;
      }
    } else if (it < P0_MOD + P0_TR + P0_CV) {
      int t = it - P0_MOD - P0_TR - 32;
      const bool isv = t >= 4096; t &= 4095;
      const float* src = isv ? p.v : p.u;
      char* dst = p.ws + (isv ? WS_V : WS_U);
      float* sc = (float*)(p.ws + (isv ? WS_SV : WS_SU));
      const int lane = tid & 63, row = t * 4 + (tid >> 6);
      const float4* s4 = (const float4*)(src + (size_t)row * 1024);
      float4 q[4]; float am = 0.f;
#pragma unroll
      for (int j = 0; j < 4; ++j) { q[j] = s4[lane + 64 * j]; am = fmaxf(am, fmaxf(fmaxf(fabsf(q[j].x), fabsf(q[j].y)), fmaxf(fabsf(q[j].z), fabsf(q[j].w)))); }
#pragma unroll
      for (int o = 32; o > 0; o >>= 1) am = fmaxf(am, __shfl_xor(am, o));
      const float scl = am > 0.f ? 384.f / am : 1.f;
      uint4 o;
      unsigned* ow = (unsigned*)&o;
#pragma unroll
      for (int j = 0; j < 4; ++j) {
        int w = 0;
        w = __builtin_amdgcn_cvt_pk_fp8_f32(q[j].x * scl, q[j].y * scl, w, false);
        w = __builtin_amdgcn_cvt_pk_fp8_f32(q[j].z * scl, q[j].w * scl, w, true);
        ow[j] = (unsigned)w;
      }
#pragma unroll
      for (int j = 0; j < 4; ++j) ((unsigned*)(dst + (size_t)row * 1024))[lane + 64 * j] = ow[j];
      if (lane == 0) sc[row] = am > 0.f ? am / 384.f : 1.f;
    } else {
      float2* rt = (float2*)(p.ws + WS_ROPE);
      for (int e = tid; e < 1024; e += 256) {
        const int pos = e >> 4, fi = e & 15;
        float freq = powf(10000.f, -(float)fi / 16.f);
        float ang = (float)pos * freq;
        rt[e] = make_float2(cosf(ang), sinf(ang));
      }
      if (tid == 0) {
        float s1 = 0.f, s2 = 0.f;
        for (int i = 0; i < 64; ++i) { s1 += p.lq1[i] * p.lk1[i]; s2 += p.lq2[i] * p.lk2[i]; }
        *(float*)(p.ws + WS_LAM) = expf(s1) - expf(s2) + 0.2f;
      }
    }
  }
}

DI void prep_row(const float* __restrict__ src, const float* __restrict__ g, const float* __restrict__ sh, const float* __restrict__ sc, short* __restrict__ dst) {
  const int lane = threadIdx.x & 63;
  float4 v[4]; float ss = 0.f;
#pragma unroll
  for (int j = 0; j < 4; ++j) { v[j] = *(const float4*)(src + 4 * (lane + 64 * j)); ss += v[j].x * v[j].x + v[j].y * v[j].y + v[j].z * v[j].z + v[j].w * v[j].w; }
  ss = wave_sum(ss);
  const float rinv = rsqrtf(ss * (1.f / 1024.f) + EPS);
#pragma unroll
  for (int j = 0; j < 4; ++j) {
    const int d = 4 * (lane + 64 * j);
    float4 gg = *(const float4*)(g + d), s1 = *(const float4*)(sc + d), s0 = *(const float4*)(sh + d);
    float y0 = v[j].x * rinv * gg.x * (1.f + s1.x) + s0.x;
    float y1 = v[j].y * rinv * gg.y * (1.f + s1.y) + s0.y;
    float y2 = v[j].z * rinv * gg.z * (1.f + s1.z) + s0.z;
    float y3 = v[j].w * rinv * gg.w * (1.f + s1.w) + s0.w;
    uint2 o; o.x = pack2(y0, y1); o.y = pack2(y2, y3);
    *(uint2*)(dst + d) = o;
  }
}
DI void phase1(const Params& p) {
  const int wave = threadIdx.x >> 6;
  const float* mod = (const float*)(p.ws + WS_MOD);
  for (int g = blockIdx.x; g < NROWS_ALL / NW; g += gridDim.x) {
    const int r = g * NW + wave, b = r / LK, t = r % LK;
    const float* src = t < CTX ? p.ctx + ((size_t)b * CTX + t) * DM : p.x + ((size_t)b * SEQ + t - CTX) * DM;
    const float* m = mod + (t < CTX ? 8 : b) * 6144;
    prep_row(src, p.n1g, m, m + 1024, (short*)(p.ws + WS_HN) + (size_t)r * DM);
  }
}
DI void phase5(const Params& p) {
  const int wave = threadIdx.x >> 6;
  const float* mod = (const float*)(p.ws + WS_MOD);
  for (int g = blockIdx.x; g < NROWS_X / NW; g += gridDim.x) {
    const int r = g * NW + wave, b = r / SEQ;
    const float* m = mod + b * 6144;
    prep_row(p.out + (size_t)r * DM, p.n2g, m + 3072, m + 4096, (short*)(p.ws + WS_HN) + (size_t)r * DM);
  }
}

DI void phase2(const Params& p, short* lds) {
  const int tid = threadIdx.x, lane = tid & 63, wave = tid >> 6, fr = lane & 31, h = lane >> 5;
  const short* HN = (const short*)(p.ws + WS_HN);
  const short* WIN = (const short*)(p.ws + WS_WIN);
  const float2* rope = (const float2*)(p.ws + WS_ROPE);
  const int xcd = blockIdx.x & 7, slot = blockIdx.x >> 3, nslots = gridDim.x >> 3;
  for (int lt = slot; lt < 17 * 18; lt += nslots) {
    const int ct = lt % 18, rt = xcd + 8 * (lt / 18);
    const int b = rt / 17, trow = (rt % 17) * 256;
    const bool isctx = trow < CTX;
    const bool qtype = (ct < 4) || (ct >= 12 && ct < 16);
    if (isctx && qtype) continue;
    const bool vtype = (ct >= 8 && ct < 12) || ct == 17;
    f32x16 acc[2][2];
    const short* gTok = HN + (size_t)rt * 256 * DM;
    const short* gW = WIN + (size_t)ct * 128 * DM;
    if (vtype) {
      const int wa = wave >> 1, wb = wave & 1;
      gemm_ml8<4, 2>(gTok, gW, lds, acc);
#pragma unroll
      for (int tb = 0; tb < 2; ++tb)
#pragma unroll
        for (int ta = 0; ta < 2; ++ta)
#pragma unroll
          for (int A = 0; A < 2; ++A) {
            const f32x16& c = acc[ta][tb];
            *(bf16x8*)(lds + (64 * wb + 32 * tb + fr) * 264 + 64 * wa + 32 * ta + 16 * A + 8 * h) =
                pack8(c[8 * A], c[8 * A + 1], c[8 * A + 2], c[8 * A + 3], c[8 * A + 4], c[8 * A + 5], c[8 * A + 6], c[8 * A + 7]);
          }
      __syncthreads();
      {
        const int c32 = tid & 31;
#pragma unroll
        for (int it = 0; it < 8; ++it) {
          const int f = (tid >> 5) + 16 * it;
          short* rowp;
          if (ct == 17) rowp = (short*)(p.ws + WS_VGT) + ((size_t)(b * 2 + (f >> 6)) * 64 + (f & 63)) * LK;
          else rowp = (short*)(p.ws + WS_VDT) + ((size_t)(b * 4 + (ct - 8)) * 128 + f) * LK;
          *(uint4*)(rowp + trow + c32 * 8) = *(const uint4*)(lds + f * 264 + c32 * 8);
        }
      }
      __syncthreads();
    } else {
      const int wa = wave >> 2, wb = wave & 3;
      gemm_ml8<2, 4>(gW, gTok, lds, acc);
      const bool norm = ct >= 12;
      const float* gn = (ct == 16) ? p.gkn : p.gqn;
#pragma unroll
      for (int tb = 0; tb < 2; ++tb) {
        const int t = trow + 64 * wb + 32 * tb + fr;
        const int s = t - CTX;
        float v[2][16];
#pragma unroll
        for (int ta = 0; ta < 2; ++ta)
#pragma unroll
          for (int i = 0; i < 16; ++i) v[ta][i] = acc[ta][tb][i];
        if (norm) {
          float ss = 0.f;
#pragma unroll
          for (int ta = 0; ta < 2; ++ta)
#pragma unroll
            for (int i = 0; i < 16; ++i) ss += v[ta][i] * v[ta][i];
          ss += __shfl_xor(ss, 32);
          const float rinv = rsqrtf(ss * (1.f / 64.f) + EPS);
#pragma unroll
          for (int ta = 0; ta < 2; ++ta)
#pragma unroll
            for (int i = 0; i < 16; ++i) v[ta][i] *= rinv * gn[32 * ta + crow(i, h)];
        }
        if (!isctx) {
          const int pr = s >> 6, pc = s & 63;
#pragma unroll
          for (int ta = 0; ta < 2; ++ta) {
            const int pos = ta ? pc : pr;
#pragma unroll
            for (int i = 0; i < 8; ++i) {
              const float2 cs = rope[pos * 16 + crow(i, h)];
              const float x1 = v[ta][i], x2 = v[ta][i + 8];
              v[ta][i] = x1 * cs.x - x2 * cs.y;
              v[ta][i + 8] = x1 * cs.y + x2 * cs.x;
            }
          }
        }
        short* srow = lds + (64 * wb + 32 * tb + fr) * 136 + 64 * wa;
#pragma unroll
        for (int ta = 0; ta < 2; ++ta)
#pragma unroll
          for (int g = 0; g < 4; ++g) {
            uint2 o; o.x = pack2(v[ta][4 * g], v[ta][4 * g + 1]); o.y = pack2(v[ta][4 * g + 2], v[ta][4 * g + 3]);
            *(uint2*)(srow + 32 * ta + 8 * g + 4 * h) = o;
          }
      }
      __syncthreads();
      {
        const int c8 = tid & 7;
#pragma unroll
        for (int it = 0; it < 8; ++it) {
          const int rowid = (tid >> 3) + 64 * it, tl = rowid & 255, hsel = rowid >> 8;
          const int t = trow + tl, s = t - CTX;
          short* dst;
          if (ct < 4)       dst = (short*)(p.ws + WS_QD) + ((size_t)(b * 8 + ct * 2 + hsel) * SEQ + s) * 64;
          else if (ct < 8)  dst = (short*)(p.ws + WS_KD) + ((size_t)(b * 8 + (ct - 4) * 2 + hsel) * LK + t) * 64;
          else if (ct < 16) dst = (short*)(p.ws + WS_QG) + ((size_t)(b * 8 + (ct - 12) * 2 + hsel) * SEQ + s) * 64;
          else              dst = (short*)(p.ws + WS_KG) + ((size_t)(b * 2 + hsel) * LK + t) * 64;
          *(uint4*)(dst + c8 * 8) = *(const uint4*)(lds + tl * 136 + hsel * 64 + c8 * 8);
        }
      }
      __syncthreads();
    }
  }
}

DI float xhalf_max(float v) { float a = v, b = v; asm volatile("s_nop 1\n\tv_permlane32_swap_b32 %0, %1\n\ts_nop 1" : "+v"(a), "+v"(b)); return fmaxf(a, b); }
#define ALD 72
#define SM_C 0.18033688011112042f
#define SM_THR 8.0f
template <int DV>
DI void attn_run(const short* __restrict__ Qp, const short* __restrict__ Kp, const short* __restrict__ Vtp, short* lds, f32x16 (&O)[DV / 32]) {
  constexpr int NDV = DV / 32;
  constexpr int BUFSZ = (64 + 128) * ALD;
  const int tid = threadIdx.x, lane = tid & 63, wave = tid >> 6, fr = lane & 31, h = lane >> 5;
  bf16x8 qf[4];
#pragma unroll
  for (int s = 0; s < 4; ++s) qf[s] = *(const bf16x8*)(Qp + (size_t)(wave * 32 + fr) * 64 + s * 16 + h * 8);
#pragma unroll
  for (int d = 0; d < NDV; ++d)
#pragma unroll
    for (int i = 0; i < 16; ++i) O[d][i] = 0.f;
  float m = -1e30f, lsum = 0.f;
  const int lrow = tid >> 3, lch = tid & 7;
  uint4 kr0, vr0, vr1 = make_uint4(0, 0, 0, 0);
  const short* pK = Kp + (size_t)lrow * 64 + lch * 8;
  const short* pV = Vtp + (size_t)lrow * LK + lch * 8;
#define A_LOAD(K0) { kr0 = *(const uint4*)(pK + (size_t)(K0) * 64); vr0 = *(const uint4*)(pV + (K0)); \
                 if (NDV == 4) { vr1 = *(const uint4*)(pV + (size_t)64 * LK + (K0)); } }
#define A_STORE(DK) { short* dk_ = (DK) + lrow * ALD + lch * 8; short* dv_ = dk_ + 64 * ALD; \
                 *(uint4*)(dk_) = kr0; *(uint4*)(dv_) = vr0; if (NDV == 4) { *(uint4*)(dv_ + 64 * ALD) = vr1; } }
  A_LOAD(0)
  A_STORE(lds)
  __syncthreads();
  A_LOAD(64)
  for (int kt = 0; kt < 68; ++kt) {
    const int buf = kt & 1;
    const short* sK = lds + buf * BUFSZ;
    const short* sV = sK + 64 * ALD;
    f32x16 S[2];
    {
      bf16x8 kf[2][4];
#pragma unroll
      for (int j = 0; j < 2; ++j)
#pragma unroll
        for (int s = 0; s < 4; ++s) kf[j][s] = *(const bf16x8*)(sK + (32 * j + fr) * ALD + s * 16 + h * 8);
#pragma unroll
      for (int j = 0; j < 2; ++j)
#pragma unroll
        for (int i = 0; i < 16; ++i) S[j][i] = 0.f;
#pragma unroll
      for (int s = 0; s < 4; ++s)
#pragma unroll
        for (int j = 0; j < 2; ++j) S[j] = MFMA(kf[j][s], qf[s], S[j]);
    }
    float mx = S[0][0];
#pragma unroll
    for (int i = 1; i < 16; ++i) mx = fmaxf(mx, S[0][i]);
#pragma unroll
    for (int i = 0; i < 16; ++i) mx = fmaxf(mx, S[1][i]);
    mx = xhalf_max(mx);
    const float mc = mx * SM_C;
    if (__any(mc > m + SM_THR)) {
      const float mn = fmaxf(m, mc);
      const float alpha = __builtin_amdgcn_exp2f(m - mn);
      m = mn; lsum *= alpha;
#pragma unroll
      for (int d = 0; d < NDV; ++d)
#pragma unroll
        for (int i = 0; i < 16; ++i) O[d][i] *= alpha;
    }
#pragma unroll
    for (int j = 0; j < 2; ++j)
#pragma unroll
      for (int i = 0; i < 16; ++i) { float pv = __builtin_amdgcn_exp2f(S[j][i] * SM_C - m); S[j][i] = pv; lsum += pv; }
    bf16x8 pf[2][2];
#pragma unroll
    for (int j = 0; j < 2; ++j)
#pragma unroll
      for (int s = 0; s < 2; ++s)
        pf[j][s] = pack8(S[j][8 * s], S[j][8 * s + 1], S[j][8 * s + 2], S[j][8 * s + 3], S[j][8 * s + 4], S[j][8 * s + 5], S[j][8 * s + 6], S[j][8 * s + 7]);
#pragma unroll
    for (int dh = 0; dh < NDV / 2; ++dh) {
      bf16x8 vf[2][2][2];
#pragma unroll
      for (int dd = 0; dd < 2; ++dd)
#pragma unroll
        for (int j = 0; j < 2; ++j)
#pragma unroll
          for (int s = 0; s < 2; ++s) vf[dd][j][s] = *(const bf16x8*)(sV + (32 * (2 * dh + dd) + fr) * ALD + 32 * j + 16 * s + 8 * h);
#pragma unroll
      for (int j = 0; j < 2; ++j)
#pragma unroll
        for (int s = 0; s < 2; ++s)
#pragma unroll
          for (int dd = 0; dd < 2; ++dd) O[2 * dh + dd] = MFMA(vf[dd][j][s], pf[j][s], O[2 * dh + dd]);
    }
    A_STORE(lds + (buf ^ 1) * BUFSZ)
    __syncthreads();
    const int k0n = (kt < 66 ? kt + 2 : 67) * 64;
    A_LOAD(k0n)
  }
#undef A_LOAD
#undef A_STORE
  lsum += __shfl_xor(lsum, 32);
  const float inv = 1.f / lsum;
#pragma unroll
  for (int d = 0; d < NDV; ++d)
#pragma unroll
    for (int i = 0; i < 16; ++i) O[d][i] *= inv;
}

DI void attn_diff_item(const Params& p, short* lds, int b, int hd, int qb) {
  const int lane = threadIdx.x & 63, wave = threadIdx.x >> 6, fr = lane & 31, h = lane >> 5;
  const short* Vt = (const short*)(p.ws + WS_VDT) + (size_t)(b * 4 + hd) * 128 * LK;
  short* rowp = (short*)(p.ws + WS_OMIX) + ((size_t)b * SEQ + qb * 256 + wave * 32 + fr) * DM + hd * 128;
  {
    f32x16 O[4];
    attn_run<128>((const short*)(p.ws + WS_QD) + ((size_t)(b * 8 + hd * 2) * SEQ + qb * 256) * 64,
                  (const short*)(p.ws + WS_KD) + (size_t)(b * 8 + hd * 2) * LK * 64, Vt, lds, O);
#pragma unroll
    for (int d = 0; d < 4; ++d)
#pragma unroll
      for (int g = 0; g < 4; ++g) {
        uint2 o; o.x = pack2(O[d][4 * g], O[d][4 * g + 1]); o.y = pack2(O[d][4 * g + 2], O[d][4 * g + 3]);
        *(uint2*)(rowp + 32 * d + 8 * g + 4 * h) = o;
      }
  }
  f32x16 O[4];
  attn_run<128>((const short*)(p.ws + WS_QD) + ((size_t)(b * 8 + hd * 2 + 1) * SEQ + qb * 256) * 64,
                (const short*)(p.ws + WS_KD) + (size_t)(b * 8 + hd * 2 + 1) * LK * 64, Vt, lds, O);
  const float lam = *(const float*)(p.ws + WS_LAM);
  float ss = 0.f;
#pragma unroll
  for (int d = 0; d < 4; ++d)
#pragma unroll
    for (int g = 0; g < 4; ++g) {
      const uint2 o1 = *(const uint2*)(rowp + 32 * d + 8 * g + 4 * h);
      float a0 = bflo(o1.x) - lam * O[d][4 * g], a1 = bfhi(o1.x) - lam * O[d][4 * g + 1];
      float a2 = bflo(o1.y) - lam * O[d][4 * g + 2], a3 = bfhi(o1.y) - lam * O[d][4 * g + 3];
      O[d][4 * g] = a0; O[d][4 * g + 1] = a1; O[d][4 * g + 2] = a2; O[d][4 * g + 3] = a3;
      ss += a0 * a0 + a1 * a1 + a2 * a2 + a3 * a3;
    }
  ss += __shfl_xor(ss, 32);
  const float rinv = rsqrtf(ss * (1.f / 128.f) + EPS) * 0.8f;
#pragma unroll
  for (int d = 0; d < 4; ++d)
#pragma unroll
    for (int g = 0; g < 4; ++g) {
      const int dv = 32 * d + 8 * g + 4 * h;
      const float4 sg = *(const float4*)(p.subln + dv);
      uint2 o; o.x = pack2(O[d][4 * g] * rinv * sg.x, O[d][4 * g + 1] * rinv * sg.y);
      o.y = pack2(O[d][4 * g + 2] * rinv * sg.z, O[d][4 * g + 3] * rinv * sg.w);
      *(uint2*)(rowp + dv) = o;
    }
}
DI void attn_gqa2_item(const Params& p, short* lds, int b, int kvh, int pair, int qb) {
  constexpr int BUFSZ = (64 + 128) * ALD;
  const int tid = threadIdx.x, lane = tid & 63, wave = tid >> 6, fr = lane & 31, h = lane >> 5;
  const int qh0 = kvh * 4 + pair * 2;
  const short* Qp0 = (const short*)(p.ws + WS_QG) + ((size_t)(b * 8 + qh0) * SEQ + qb * 256) * 64;
  const short* Qp1 = Qp0 + (size_t)SEQ * 64;
  const short* Kp = (const short*)(p.ws + WS_KG) + (size_t)(b * 2 + kvh) * LK * 64;
  const short* Vtp = (const short*)(p.ws + WS_VGT) + (size_t)(b * 2 + kvh) * 64 * LK;
  bf16x8 qf[2][4];
#pragma unroll
  for (int s = 0; s < 4; ++s) {
    qf[0][s] = *(const bf16x8*)(Qp0 + (size_t)(wave * 32 + fr) * 64 + s * 16 + h * 8);
    qf[1][s] = *(const bf16x8*)(Qp1 + (size_t)(wave * 32 + fr) * 64 + s * 16 + h * 8);
  }
  f32x16 O[2][2];
#pragma unroll
  for (int a = 0; a < 2; ++a)
#pragma unroll
    for (int d = 0; d < 2; ++d)
#pragma unroll
      for (int i = 0; i < 16; ++i) O[a][d][i] = 0.f;
  float m[2] = {-1e30f, -1e30f}, lsum[2] = {0.f, 0.f};
  const int lrow = tid >> 3, lch = tid & 7;
  uint4 kr0, vr0;
  const short* pK = Kp + (size_t)lrow * 64 + lch * 8;
  const short* pV = Vtp + (size_t)lrow * LK + lch * 8;
#define A_LOAD(K0) { kr0 = *(const uint4*)(pK + (size_t)(K0) * 64); vr0 = *(const uint4*)(pV + (K0)); }
#define A_STORE(DK) { short* dk_ = (DK) + lrow * ALD + lch * 8; short* dv_ = dk_ + 64 * ALD; *(uint4*)(dk_) = kr0; *(uint4*)(dv_) = vr0; }
  A_LOAD(0)
  A_STORE(lds)
  __syncthreads();
  A_LOAD(64)
  for (int kt = 0; kt < 68; ++kt) {
    const int buf = kt & 1;
    const short* sK = lds + buf * BUFSZ;
    const short* sV = sK + 64 * ALD;
    f32x16 S[2][2];
    {
      bf16x8 kf[2][4];
#pragma unroll
      for (int j = 0; j < 2; ++j)
#pragma unroll
        for (int s = 0; s < 4; ++s) kf[j][s] = *(const bf16x8*)(sK + (32 * j + fr) * ALD + s * 16 + h * 8);
#pragma unroll
      for (int a = 0; a < 2; ++a)
#pragma unroll
        for (int j = 0; j < 2; ++j)
#pragma unroll
          for (int i = 0; i < 16; ++i) S[a][j][i] = 0.f;
#pragma unroll
      for (int s = 0; s < 4; ++s)
#pragma unroll
        for (int j = 0; j < 2; ++j)
#pragma unroll
          for (int a = 0; a < 2; ++a) S[a][j] = MFMA(kf[j][s], qf[a][s], S[a][j]);
    }
    bf16x8 pf[2][2][2];
#pragma unroll
    for (int a = 0; a < 2; ++a) {
      float mx = S[a][0][0];
#pragma unroll
      for (int i = 1; i < 16; ++i) mx = fmaxf(mx, S[a][0][i]);
#pragma unroll
      for (int i = 0; i < 16; ++i) mx = fmaxf(mx, S[a][1][i]);
      mx = xhalf_max(mx);
      const float mc = mx * SM_C;
      if (__any(mc > m[a] + SM_THR)) {
        const float mn = fmaxf(m[a], mc);
        const float alpha = __builtin_amdgcn_exp2f(m[a] - mn);
        m[a] = mn; lsum[a] *= alpha;
#pragma unroll
        for (int d = 0; d < 2; ++d)
#pragma unroll
          for (int i = 0; i < 16; ++i) O[a][d][i] *= alpha;
      }
#pragma unroll
      for (int j = 0; j < 2; ++j)
#pragma unroll
        for (int i = 0; i < 16; ++i) { float pv = __builtin_amdgcn_exp2f(S[a][j][i] * SM_C - m[a]); S[a][j][i] = pv; lsum[a] += pv; }
#pragma unroll
      for (int j = 0; j < 2; ++j)
#pragma unroll
        for (int s = 0; s < 2; ++s)
          pf[a][j][s] = pack8(S[a][j][8 * s], S[a][j][8 * s + 1], S[a][j][8 * s + 2], S[a][j][8 * s + 3], S[a][j][8 * s + 4], S[a][j][8 * s + 5], S[a][j][8 * s + 6], S[a][j][8 * s + 7]);
    }
    {
      bf16x8 vf[2][2][2];
#pragma unroll
      for (int d = 0; d < 2; ++d)
#pragma unroll
        for (int j = 0; j < 2; ++j)
#pragma unroll
          for (int s = 0; s < 2; ++s) vf[d][j][s] = *(const bf16x8*)(sV + (32 * d + fr) * ALD + 32 * j + 16 * s + 8 * h);
#pragma unroll
      for (int j = 0; j < 2; ++j)
#pragma unroll
        for (int s = 0; s < 2; ++s)
#pragma unroll
          for (int d = 0; d < 2; ++d)
#pragma unroll
            for (int a = 0; a < 2; ++a) O[a][d] = MFMA(vf[d][j][s], pf[a][j][s], O[a][d]);
    }
    A_STORE(lds + (buf ^ 1) * BUFSZ)
    __syncthreads();
    const int k0n = (kt < 66 ? kt + 2 : 67) * 64;
    A_LOAD(k0n)
  }
#undef A_LOAD
#undef A_STORE
#pragma unroll
  for (int a = 0; a < 2; ++a) {
    float l = lsum[a]; l += __shfl_xor(l, 32);
    const float inv = 1.f / l;
    short* rowp = (short*)(p.ws + WS_OMIX) + ((size_t)b * SEQ + qb * 256 + wave * 32 + fr) * DM + 512 + (qh0 + a) * 64;
#pragma unroll
    for (int d = 0; d < 2; ++d)
#pragma unroll
      for (int g = 0; g < 4; ++g) {
        uint2 o; o.x = pack2(O[a][d][4 * g] * inv, O[a][d][4 * g + 1] * inv); o.y = pack2(O[a][d][4 * g + 2] * inv, O[a][d][4 * g + 3] * inv);
        *(uint2*)(rowp + 32 * d + 8 * g + 4 * h) = o;
      }
  }
}
DI void phase3(const Params& p, short* lds) {
  const int xcd = blockIdx.x & 7, slot = blockIdx.x >> 3, nslots = gridDim.x >> 3;
  for (int j = slot; j < 64; j += nslots) {
    const int grp = xcd * 4 + (j >> 4);
    attn_diff_item(p, lds, grp >> 2, grp & 3, j & 15);
  }
  for (int j = slot; j < 64; j += nslots) {
    const int sg = xcd * 2 + (j >> 5);
    attn_gqa2_item(p, lds, sg >> 1, sg & 1, (j & 31) >> 4, j & 15);
  }
}

DI void phase4(const Params& p, short* lds) {
  const int tid = threadIdx.x, lane = tid & 63, wave = tid >> 6, wa = wave >> 1, wb = wave & 1, fr = lane & 31, h = lane >> 5;
  const float* mod = (const float*)(p.ws + WS_MOD);
  float* stg = (float*)lds;
  const int xcd = blockIdx.x & 7, slot = blockIdx.x >> 3, nslots = gridDim.x >> 3;
  for (int lt = slot; lt < 16 * 8; lt += nslots) {
    const int ct = lt & 7, rt = xcd + 8 * (lt >> 3);
    f32x16 acc[2][2];
    gemm_ml8<4, 2>((const short*)(p.ws + WS_OMIX) + (size_t)rt * 256 * DM, (const short*)(p.ws + WS_WOUT) + (size_t)ct * 128 * DM, lds, acc);
    const int b = rt >> 4;
#pragma unroll
    for (int tb = 0; tb < 2; ++tb)
#pragma unroll
      for (int ta = 0; ta < 2; ++ta)
#pragma unroll
        for (int i = 0; i < 16; ++i) stg[(64 * wa + 32 * ta + crow(i, h)) * 132 + 64 * wb + 32 * tb + fr] = acc[ta][tb][i];
    __syncthreads();
    const int n4 = (tid & 31) * 4, r0 = tid >> 5;
    const float4 g1 = *(const float4*)(mod + b * 6144 + 2048 + ct * 128 + n4);
#pragma unroll 4
    for (int it = 0; it < 16; ++it) {
      const int r = r0 + 16 * it;
      const size_t gi = ((size_t)rt * 256 + r) * DM + ct * 128 + n4;
      const float4 a = *(const float4*)(stg + r * 132 + n4), xv = *(const float4*)(p.x + gi);
      *(float4*)(p.out + gi) = make_float4(xv.x + g1.x * a.x, xv.y + g1.y * a.y, xv.z + g1.z * a.z, xv.w + g1.w * a.w);
    }
    __syncthreads();
  }
}

DI void cex(int& a, int& b, bool desc) { int mx = max(a, b), mn = min(a, b); a = desc ? mx : mn; b = desc ? mn : mx; }
DI void merge16(int (&a)[16], bool desc) {
#pragma unroll
  for (int j = 8; j > 0; j >>= 1)
#pragma unroll
    for (int i = 0; i < 16; ++i) { const int l = i ^ j; if (l > i) cex(a[i], a[l], desc); }
}
#define QLD 136
DI void phase6(const Params& p, short* lds) {
  const int tid = threadIdx.x, lane = tid & 63, wave = tid >> 6, wa = wave >> 2, wb = wave & 3, fr = lane & 31, h = lane >> 5;
  short* sQ = lds; short* sK = lds + 256 * QLD;
  int* TK1 = (int*)(p.ws + WS_QD);
  const int xcd = blockIdx.x & 7, slot = blockIdx.x >> 3, nslots = gridDim.x >> 3;
  for (int lt = slot; lt < 16 * 16; lt += nslots) {
    const int hp = lt & 15, rt = xcd + 8 * (lt >> 4);
    {
      f32x16 acc[2][2];
      gemm_ml8<2, 4>((const short*)(p.ws + WS_WQ) + (size_t)hp * 128 * DM, (const short*)(p.ws + WS_HN) + (size_t)rt * 256 * DM, lds, acc);
#pragma unroll
      for (int tb = 0; tb < 2; ++tb)
#pragma unroll
        for (int ta = 0; ta < 2; ++ta)
#pragma unroll
          for (int g = 0; g < 4; ++g) {
            const f32x16& c = acc[ta][tb];
            uint2 o; o.x = pack2(c[4 * g], c[4 * g + 1]); o.y = pack2(c[4 * g + 2], c[4 * g + 3]);
            *(uint2*)(sQ + (64 * wb + 32 * tb + fr) * QLD + 64 * wa + 32 * ta + 8 * g + 4 * h) = o;
          }
    }
    {
      const short* skg = (const short*)(p.ws + WS_SK) + (size_t)hp * 128 * 128;
#pragma unroll
      for (int r = 0; r < 4; ++r) { const int c = tid + 512 * r; *(uint4*)(sK + (c >> 4) * QLD + (c & 15) * 8) = *(const uint4*)(skg + c * 8); }
    }
    __syncthreads();
    int v[64];
    {
      f32x16 sc[4];
#pragma unroll
      for (int k = 0; k < 4; ++k)
#pragma unroll
        for (int i = 0; i < 16; ++i) sc[k][i] = 0.f;
#pragma unroll
      for (int ks = 0; ks < 8; ++ks) {
        bf16x8 qf = *(const bf16x8*)(sQ + (32 * wave + fr) * QLD + ks * 16 + 8 * h);
#pragma unroll
        for (int k = 0; k < 4; ++k) {
          bf16x8 kf = *(const bf16x8*)(sK + (32 * k + fr) * QLD + ks * 16 + 8 * h);
          sc[k] = MFMA(kf, qf, sc[k]);
        }
      }
#pragma unroll
      for (int k = 0; k < 4; ++k)
#pragma unroll
        for (int i = 0; i < 16; ++i) {
          int key = __float_as_int(sc[k][i]); key ^= (key >> 31) & 0x7fffffff;
          v[16 * k + i] = (key & ~127) | (127 - (32 * k + crow(i, h)));
        }
    }
#pragma unroll
    for (int k = 2; k <= 16; k <<= 1)
#pragma unroll
      for (int j = k >> 1; j > 0; j >>= 1)
#pragma unroll
        for (int i = 0; i < 64; ++i) { const int l = i ^ j; if (l > i) cex(v[i], v[l], (i & k) != 0); }
    int a[16], bb[16];
#pragma unroll
    for (int i = 0; i < 16; ++i) { a[i] = max(v[i], v[16 + i]); bb[i] = max(v[32 + i], v[48 + i]); }
    merge16(a, false); merge16(bb, true);
#pragma unroll
    for (int i = 0; i < 16; ++i) a[i] = max(a[i], bb[i]);
    merge16(a, true);
#pragma unroll
    for (int i = 0; i < 16; ++i) bb[i] = __shfl_xor(a[i], 32);
#pragma unroll
    for (int i = 0; i < 16; ++i) a[i] = max(a[i], bb[15 - i]);
    merge16(a, true);
    {
      int* dst = TK1 + ((size_t)rt * 256 + 32 * wave + fr) * 256 + hp * 16 + 8 * h;
      int4 o0, o1;
      o0.x = h ? a[8] : a[0]; o0.y = h ? a[9] : a[1]; o0.z = h ? a[10] : a[2]; o0.w = h ? a[11] : a[3];
      o1.x = h ? a[12] : a[4]; o1.y = h ? a[13] : a[5]; o1.z = h ? a[14] : a[6]; o1.w = h ? a[15] : a[7];
      *(int4*)dst = o0; *(int4*)(dst + 4) = o1;
    }
    __syncthreads();
  }
}

DI float key2val(int k) { k &= ~127; k ^= (k >> 31) & 0x7fffffff; return __int_as_float(k); }
DI void phase7(const Params& p) {
  const int* TK1 = (const int*)(p.ws + WS_QD);
  for (int blk = blockIdx.x; blk < NROWS_X * 8 / NT; blk += gridDim.x) {
    const int item = blk * NT + threadIdx.x;
    const int4* src = (const int4*)(TK1 + (size_t)item * 32);
    int ka[16], kb[16];
#pragma unroll
    for (int q = 0; q < 4; ++q) { int4 t = src[q]; ka[4 * q] = t.x; ka[4 * q + 1] = t.y; ka[4 * q + 2] = t.z; ka[4 * q + 3] = t.w; }
#pragma unroll
    for (int q = 0; q < 4; ++q) { int4 t = src[4 + q]; kb[4 * q] = t.x; kb[4 * q + 1] = t.y; kb[4 * q + 2] = t.z; kb[4 * q + 3] = t.w; }
    float cv[50]; int cid[50];
    {
      int n = 0;
#pragma unroll
      for (int i = 0; i < 16; ++i)
#pragma unroll
        for (int j = 0; j < 16; ++j)
          if ((i + 1) * (j + 1) <= 16) {
            cv[n] = key2val(ka[i]) + key2val(kb[j]);
            cid[n] = (127 - (ka[i] & 127)) * 128 + (127 - (kb[j] & 127));
            ++n;
          }
    }
    float best[16]; int bid[16];
#pragma unroll
    for (int r = 0; r < 16; ++r) {
      float mv = cv[0]; int mi = cid[0];
#pragma unroll
      for (int c = 1; c < 50; ++c) if (cv[c] > mv) { mv = cv[c]; mi = cid[c]; }
      best[r] = mv; bid[r] = mi;
#pragma unroll
      for (int c = 0; c < 50; ++c) if (cid[c] == mi) cv[c] = -3.0e38f;
    }
    float sum = 0.f;
#pragma unroll
    for (int r = 15; r >= 0; --r) { best[r] = __expf(best[r] - best[0]); sum += best[r]; }
    const float inv = 1.f / sum;
    unsigned short* ids = (unsigned short*)(p.ws + WS_IDS) + (size_t)item * 16;
    float* gw = (float*)(p.ws + WS_GW) + (size_t)item * 16;
    uint4 i0, i1;
    i0.x = bid[0] | (bid[1] << 16); i0.y = bid[2] | (bid[3] << 16); i0.z = bid[4] | (bid[5] << 16); i0.w = bid[6] | (bid[7] << 16);
    i1.x = bid[8] | (bid[9] << 16); i1.y = bid[10] | (bid[11] << 16); i1.z = bid[12] | (bid[13] << 16); i1.w = bid[14] | (bid[15] << 16);
    *(uint4*)ids = i0; *(uint4*)(ids + 8) = i1;
#pragma unroll
    for (int r = 0; r < 4; ++r) *(float4*)(gw + 4 * r) = make_float4(best[4 * r] * inv, best[4 * r + 1] * inv, best[4 * r + 2] * inv, best[4 * r + 3] * inv);
  }
}

DI void cvt16(const uint4& r, float (&f)[16]) {
  const unsigned w[4] = {r.x, r.y, r.z, r.w};
#pragma unroll
  for (int j = 0; j < 4; ++j) {
    f32x2_t lo = __builtin_amdgcn_cvt_pk_f32_fp8((int)w[j], false), hi = __builtin_amdgcn_cvt_pk_f32_fp8((int)w[j], true);
    f[4 * j] = lo[0]; f[4 * j + 1] = lo[1]; f[4 * j + 2] = hi[0]; f[4 * j + 3] = hi[1];
  }
}
DI void unpack_ids(const uint4& a, const uint4& b, int (&id)[16]) {
  const unsigned w[8] = {a.x, a.y, a.z, a.w, b.x, b.y, b.z, b.w};
#pragma unroll
  for (int j = 0; j < 8; ++j) { id[2 * j] = w[j] & 0xffffu; id[2 * j + 1] = w[j] >> 16; }
}
DI float dpp_f(float v, const int ctrl_sel) {
  const int x = __builtin_bit_cast(int, v);
  int r;
  if (ctrl_sel == 0) r = __builtin_amdgcn_update_dpp(0, x, 0xB1, 0xF, 0xF, true);
  else if (ctrl_sel == 1) r = __builtin_amdgcn_update_dpp(0, x, 0x4E, 0xF, 0xF, true);
  else if (ctrl_sel == 2) r = __builtin_amdgcn_update_dpp(0, x, 0x141, 0xF, 0xF, true);
  else r = __builtin_amdgcn_update_dpp(0, x, 0x128, 0xF, 0xF, true);
  return __builtin_bit_cast(float, r);
}
DI void phase8(const Params& p) {
  const int lane = threadIdx.x & 63, wave = threadIdx.x >> 6, c = lane & 7, s = lane >> 3;
  const int o = blockIdx.x & 7, slot = blockIdx.x >> 3, nslots = gridDim.x >> 3;
  const unsigned char* U8 = (const unsigned char*)(p.ws + WS_U) + 128 * o + 16 * c;
  const unsigned short* IDS = (const unsigned short*)(p.ws + WS_IDS) + 16 * s;
  const short* HX = (const short*)(p.ws + WS_HN) + 128 * o + 16 * c;
  float* PDo = (float*)(p.ws + WS_PD) + (size_t)o * NROWS_X * 128 + 16 * s + 2 * c;
  const int K = (NROWS_X / NW - slot + nslots - 1) / nslots;
  if (K <= 0) return;
  auto tokof = [&](int k) __attribute__((always_inline)) { return (slot + k * nslots) * NW + wave; };
  auto issue = [&](const uint4& pa, const uint4& pb, uint4 (&r)[16]) __attribute__((always_inline)) {
    int id[16]; unpack_ids(pa, pb, id);
#pragma unroll
    for (int j = 0; j < 16; ++j) r[j] = *(const uint4*)(U8 + (size_t)id[j] * 1024);
  };
  auto compute = [&](int tok, const uint4 (&r)[16], const uint4& xa, const uint4& xb) __attribute__((always_inline)) {
    f32x2_t xf[8];
    xf[0] = (f32x2_t){bflo(xa.x), bfhi(xa.x)}; xf[1] = (f32x2_t){bflo(xa.y), bfhi(xa.y)}; xf[2] = (f32x2_t){bflo(xa.z), bfhi(xa.z)}; xf[3] = (f32x2_t){bflo(xa.w), bfhi(xa.w)};
    xf[4] = (f32x2_t){bflo(xb.x), bfhi(xb.x)}; xf[5] = (f32x2_t){bflo(xb.y), bfhi(xb.y)}; xf[6] = (f32x2_t){bflo(xb.z), bfhi(xb.z)}; xf[7] = (f32x2_t){bflo(xb.w), bfhi(xb.w)};
    float d[16];
#pragma unroll
    for (int j = 0; j < 16; ++j) {
      const unsigned w[4] = {r[j].x, r[j].y, r[j].z, r[j].w};
      f32x2_t a2 = {0.f, 0.f};
#pragma unroll
      for (int q = 0; q < 4; ++q) {
        a2 += __builtin_amdgcn_cvt_pk_f32_fp8((int)w[q], false) * xf[2 * q];
        a2 += __builtin_amdgcn_cvt_pk_f32_fp8((int)w[q], true) * xf[2 * q + 1];
      }
      float t = a2[0] + a2[1];
      t += dpp_f(t, 0); t += dpp_f(t, 1); t += dpp_f(t, 2);
      d[j] = t;
    }
    float2 o2 = make_float2(d[0], d[1]);
#pragma unroll
    for (int j = 1; j < 8; ++j) if (c == j) o2 = make_float2(d[2 * j], d[2 * j + 1]);
    *(float2*)(PDo + (size_t)tok * 128) = o2;
  };
  auto ldids = [&](int tok, uint4& a, uint4& b) __attribute__((always_inline)) { a = *(const uint4*)(IDS + (size_t)tok * 128); b = *(const uint4*)(IDS + (size_t)tok * 128 + 8); };
  auto ldx = [&](int tok, uint4& a, uint4& b) __attribute__((always_inline)) { a = *(const uint4*)(HX + (size_t)tok * DM); b = *(const uint4*)(HX + (size_t)tok * DM + 8); };
  uint4 rA[16], rB[16], i0a, i0b, i1a, i1b, x0a, x0b, x1a, x1b;
  ldids(tokof(0), i0a, i0b); ldx(tokof(0), x0a, x0b);
  i1a = i0a; i1b = i0b; x1a = x0a; x1b = x0b;
  if (K > 1) ldids(tokof(1), i1a, i1b);
  issue(i0a, i0b, rA);
  for (int k = 0; k < K; k += 2) {
    if (k + 1 < K) { issue(i1a, i1b, rB); ldx(tokof(k + 1), x1a, x1b); }
    if (k + 2 < K) ldids(tokof(k + 2), i0a, i0b);
    compute(tokof(k), rA, x0a, x0b);
    if (k + 1 >= K) break;
    if (k + 2 < K) { issue(i0a, i0b, rA); ldx(tokof(k + 2), x0a, x0b); }
    if (k + 3 < K) ldids(tokof(k + 3), i1a, i1b);
    compute(tokof(k + 1), rB, x1a, x1b);
  }
}
DI void phase9(const Params& p) {
  const float* PD = (const float*)(p.ws + WS_PD);
  float* GW = (float*)(p.ws + WS_GW);
  const unsigned short* IDS = (const unsigned short*)(p.ws + WS_IDS);
  const float* SV = (const float*)(p.ws + WS_SV);
  const float* SU = (const float*)(p.ws + WS_SU);
  for (int blk = blockIdx.x; blk < NROWS_X * 128 / NT; blk += gridDim.x) {
    const size_t idx = (size_t)blk * NT + threadIdx.x;
    float d = 0.f;
#pragma unroll
    for (int o = 0; o < 8; ++o) d += PD[(size_t)o * NROWS_X * 128 + idx];
    const int id = IDS[idx];
    d *= SU[id];
    const float a = 0.5f * d * (1.f + erff(d * 0.70710678118654752f));
    GW[idx] = GW[idx] * a * SV[id];
  }
}
DI void phase10(const Params& p) {
  const int lane = threadIdx.x & 63, wave = threadIdx.x >> 6, c = lane & 7, s = lane >> 3;
  const int o = blockIdx.x & 7, slot = blockIdx.x >> 3, nslots = gridDim.x >> 3;
  const unsigned char* V8 = (const unsigned char*)(p.ws + WS_V) + 128 * o + 16 * c;
  const float* mod = (const float*)(p.ws + WS_MOD);
  const unsigned short* IDS = (const unsigned short*)(p.ws + WS_IDS) + 16 * s;
  const float* GW = (const float*)(p.ws + WS_GW) + 16 * s;
  const int col = 128 * o + 16 * c + 2 * s;
  const int K = (NROWS_X / NW - slot + nslots - 1) / nslots;
  if (K <= 0) return;
  const bool b2 = (s & 4) != 0, b1 = (s & 2) != 0, b0 = (s & 1) != 0;
  auto tokof = [&](int k) __attribute__((always_inline)) { return (slot + k * nslots) * NW + wave; };
  auto issue = [&](const uint4& pa, const uint4& pb, uint4 (&r)[16]) __attribute__((always_inline)) {
    int id[16]; unpack_ids(pa, pb, id);
#pragma unroll
    for (int j = 0; j < 16; ++j) r[j] = *(const uint4*)(V8 + (size_t)id[j] * 1024);
  };
  auto compute = [&](int tok, const uint4 (&r)[16], const float (&w)[16]) __attribute__((always_inline)) {
    f32x2_t acc[8];
#pragma unroll
    for (int j = 0; j < 8; ++j) acc[j] = (f32x2_t){0.f, 0.f};
#pragma unroll
    for (int j = 0; j < 16; ++j) {
      const unsigned ww[4] = {r[j].x, r[j].y, r[j].z, r[j].w};
      const f32x2_t w2 = {w[j], w[j]};
#pragma unroll
      for (int q = 0; q < 4; ++q) {
        acc[2 * q] += __builtin_amdgcn_cvt_pk_f32_fp8((int)ww[q], false) * w2;
        acc[2 * q + 1] += __builtin_amdgcn_cvt_pk_f32_fp8((int)ww[q], true) * w2;
      }
    }
    float a[16];
#pragma unroll
    for (int j = 0; j < 8; ++j) { a[2 * j] = acc[j][0]; a[2 * j + 1] = acc[j][1]; }
    float k1[8], k2[4], k3[2];
#pragma unroll
    for (int j = 0; j < 8; ++j) { const float keep = b2 ? a[8 + j] : a[j], send = b2 ? a[j] : a[8 + j]; k1[j] = keep + __shfl_xor(send, 32); }
#pragma unroll
    for (int j = 0; j < 4; ++j) { const float keep = b1 ? k1[4 + j] : k1[j], send = b1 ? k1[j] : k1[4 + j]; k2[j] = keep + __shfl_xor(send, 16); }
#pragma unroll
    for (int j = 0; j < 2; ++j) { const float keep = b0 ? k2[2 + j] : k2[j], send = b0 ? k2[j] : k2[2 + j]; k3[j] = keep + dpp_f(send, 3); }
    const int b = tok / SEQ;
    float* orow = p.out + (size_t)tok * DM + col;
    const float2 xm = *(const float2*)orow, gg = *(const float2*)(mod + b * 6144 + 5120 + col);
    float2 r2; r2.x = xm.x + gg.x * k3[0]; r2.y = xm.y + gg.y * k3[1];
    *(float2*)orow = r2;
    float ss = wave_sum(r2.x * r2.x + r2.y * r2.y);
    if (lane == 0) ((float*)(p.ws + WS_PS))[(size_t)o * NROWS_X + tok] = ss;
  };
  auto ldids = [&](int tok, uint4& a, uint4& b) __attribute__((always_inline)) { a = *(const uint4*)(IDS + (size_t)tok * 128); b = *(const uint4*)(IDS + (size_t)tok * 128 + 8); };
  auto ldw = [&](int tok, float (&w)[16]) __attribute__((always_inline)) {
#pragma unroll
    for (int q = 0; q < 4; ++q) { const float4 t = *(const float4*)(GW + (size_t)tok * 128 + 4 * q); w[4 * q] = t.x; w[4 * q + 1] = t.y; w[4 * q + 2] = t.z; w[4 * q + 3] = t.w; }
  };
  uint4 rA[16], rB[16], i0a, i0b, i1a, i1b; float w0[16], w1[16];
  ldids(tokof(0), i0a, i0b); ldw(tokof(0), w0);
  i1a = i0a; i1b = i0b;
#pragma unroll
  for (int q = 0; q < 16; ++q) w1[q] = w0[q];
  if (K > 1) ldids(tokof(1), i1a, i1b);
  issue(i0a, i0b, rA);
  for (int k = 0; k < K; k += 2) {
    if (k + 1 < K) { issue(i1a, i1b, rB); ldw(tokof(k + 1), w1); }
    if (k + 2 < K) ldids(tokof(k + 2), i0a, i0b);
    compute(tokof(k), rA, w0);
    if (k + 1 >= K) break;
    if (k + 2 < K) { issue(i0a, i0b, rA); ldw(tokof(k + 2), w0); }
    if (k + 3 < K) ldids(tokof(k + 3), i1a, i1b);
    compute(tokof(k + 1), rB, w1);
  }
}
DI void phase11(const Params& p) {
  const int lane = threadIdx.x & 63, wave = threadIdx.x >> 6;
  const float* PS = (const float*)(p.ws + WS_PS);
  for (int g = blockIdx.x; g < NROWS_X / NW; g += gridDim.x) {
    const int tok = g * NW + wave;
    float ss = 0.f;
#pragma unroll
    for (int o = 0; o < 8; ++o) ss += PS[(size_t)o * NROWS_X + tok];
    const float rinv = rsqrtf(ss * (1.f / 1024.f) + EPS);
    float* orow = p.out + (size_t)tok * DM;
#pragma unroll
    for (int j = 0; j < 4; ++j) {
      const int d = 4 * (lane + 64 * j);
      const float4 v = *(const float4*)(orow + d), fg = *(const float4*)(p.fng + d);
      *(float4*)(orow + d) = make_float4(v.x * rinv * fg.x, v.y * rinv * fg.y, v.z * rinv * fg.z, v.w * rinv * fg.w);
    }
  }
}

#define WS_BAR WS_END
#define XB_TMO      128
#define XB_XCNT(j)  (256  + 64 * (j))
#define XB_XSUB(j)  (1280 + 64 * (j))
#define XB_XGEN(j)  (2304 + 64 * (j))
#define XB_TOP      3328
#define XB_TOPGEN   3392
#define XCD_BAR_WORDS 3456
#define XB_SPIN_CAP (1u << 18)
#define LAS __attribute__((address_space(3)))

__device__ __forceinline__ unsigned xb_ld(unsigned* p)              { return __hip_atomic_load(p, __ATOMIC_RELAXED, __HIP_MEMORY_SCOPE_AGENT); }
__device__ __forceinline__ unsigned xb_add(unsigned* p, unsigned v) { return __hip_atomic_fetch_add(p, v, __ATOMIC_RELAXED, __HIP_MEMORY_SCOPE_AGENT); }
__device__ __forceinline__ unsigned xb_xcc_id() { return (unsigned)__builtin_amdgcn_s_getreg((3 << 11) | 20) & 0xFu; }
#define XB_SPIN(cond, bar) do { unsigned _sp = 0; while (cond) { __builtin_amdgcn_s_sleep(1); \
    if ((++_sp & 255u) == 0u) { if (xb_ld(&(bar)[XB_TMO])) break; if (_sp > XB_SPIN_CAP) { atomicAdd(&(bar)[XB_TMO], 1u); break; } } } } while (0)

struct XcdBarrier {
    unsigned* bar; unsigned x;
    volatile LAS unsigned* st;
};

__device__ __forceinline__ XcdBarrier xcd_barrier_post(unsigned* bar, volatile LAS unsigned* st) {
    XcdBarrier b; b.bar = bar; b.x = xb_xcc_id(); b.st = st;
    if (threadIdx.x == 0) (void)xb_add(&bar[XB_XCNT(b.x)], 1u);
    return b;
}
__device__ __forceinline__ void xcd_barrier_complete(unsigned* bar, unsigned x, unsigned& nloc, unsigned& nx) {
    const unsigned G = gridDim.x * gridDim.y * gridDim.z;
    unsigned sum, cnt, mine, sp = 0u;
    for (;;) {
        sum = 0u; cnt = 0u; mine = 0u;
#pragma unroll
        for (unsigned j = 0; j < 16; ++j) { const unsigned c = xb_ld(&bar[XB_XCNT(j)]); sum += c; cnt += (c > 0u) ? 1u : 0u; mine = (j == x) ? c : mine; }
        if (sum == G) break;
        __builtin_amdgcn_s_sleep(1);
        if ((++sp & 255u) == 0u) { if (xb_ld(&bar[XB_TMO])) break; if (sp > XB_SPIN_CAP) { atomicAdd(&bar[XB_TMO], 1u); break; } }
    }
    nloc = mine > 0u ? mine : 1u; nx = cnt > 0u ? cnt : 1u;
}

__device__ __forceinline__ void xcd_barrier(const XcdBarrier& b) {
    asm volatile("s_waitcnt vmcnt(0)" ::: "memory");
    __syncthreads();
    if (threadIdx.x == 0) {
        unsigned* bar = b.bar;
        __builtin_amdgcn_s_waitcnt(0);
        unsigned nloc = b.st[0], nx = b.st[1];
        if (nloc == 0u) { xcd_barrier_complete(bar, b.x, nloc, nx); b.st[0] = nloc; b.st[1] = nx; }
        const unsigned old = xb_add(&bar[XB_XSUB(b.x)], 1u);
        const unsigned gen = old / nloc;
        if (old + 1u == (gen + 1u) * nloc) {
            __builtin_amdgcn_fence(__ATOMIC_RELEASE, "agent");
            asm volatile("s_waitcnt vmcnt(0)" ::: "memory");
            const unsigned og = xb_add(&bar[XB_TOP], 1u);
            const unsigned tg = og / nx;
            if (og + 1u == (tg + 1u) * nx) xb_add(&bar[XB_TOPGEN], 1u);
            else XB_SPIN(xb_ld(&bar[XB_TOPGEN]) == tg, bar);
            __builtin_amdgcn_fence(__ATOMIC_ACQUIRE, "agent");
            xb_add(&bar[XB_XGEN(b.x)], 1u);
            asm volatile("s_waitcnt vmcnt(0)" ::: "memory");
        } else {
            XB_SPIN(xb_ld(&bar[XB_XGEN(b.x)]) == gen, bar);
            __builtin_amdgcn_fence(__ATOMIC_ACQUIRE, "agent");
            asm volatile("s_waitcnt vmcnt(0)" ::: "memory");
        }
    }
    __syncthreads();
}

#ifndef MINW
#define MINW 2
#endif
#ifndef REP_MASK
#define REP_MASK 0
#endif
#define RUN_PHASE(N, CALL) if (ph_lo <= N && N <= ph_hi) { if (N > ph_lo) xcd_barrier(xb); CALL; if ((REP_MASK >> N) & 1) { xcd_barrier(xb); CALL; } }
__global__ void __launch_bounds__(NT) fwd_kernel(Params p, int ph_lo, int ph_hi) {
  __shared__ __attribute__((aligned(16))) short lds[67584];
  cg::grid_group grid = cg::this_grid();
  if (ph_hi == 0x7fffffff) grid.sync();
  __shared__ uint4 xb_words;
  if (threadIdx.x == 0) xb_words = make_uint4(0u, 0u, 0u, 0u);
  __syncthreads();
  const XcdBarrier xb = xcd_barrier_post((unsigned*)(p.ws + WS_BAR), (volatile LAS unsigned*)&xb_words);
  RUN_PHASE(0, phase0(p, (float*)lds))
  RUN_PHASE(1, phase1(p))
  RUN_PHASE(2, phase2(p, lds))
  RUN_PHASE(3, phase3(p, lds))
  RUN_PHASE(4, phase4(p, lds))
  RUN_PHASE(5, phase5(p))
  RUN_PHASE(6, phase6(p, lds))
  RUN_PHASE(7, phase7(p))
  RUN_PHASE(8, phase8(p))
  RUN_PHASE(9, phase9(p))
  RUN_PHASE(10, phase10(p))
  RUN_PHASE(11, phase11(p))
}

#ifndef N_LAUNCH_MODE
#define N_LAUNCH_MODE 0
#endif

extern "C" void kernel_launch(void* const* d_in, const int* in_sizes, int n_in, void* d_out, int out_size, void* d_ws, size_t ws_size, hipStream_t stream) {
  static int grid_blocks = 0;
  if (!grid_blocks) {
    int dev = 0, cus = 0, per_cu = 0;
    hipGetDevice(&dev);
    hipDeviceGetAttribute(&cus, hipDeviceAttributeMultiprocessorCount, dev);
    hipOccupancyMaxActiveBlocksPerMultiprocessor(&per_cu, fwd_kernel, NT, 0);
    if (per_cu > 1) per_cu = 1;
    if (per_cu < 1) per_cu = 1;
    grid_blocks = cus * per_cu;
  }
  Params p{};
  const float** f = (const float**)&p;
  for (int i = 0; i < 22; ++i) f[i] = (const float*)d_in[i];
  p.out = (float*)d_out;
  p.ws = (char*)d_ws;
#if N_LAUNCH_MODE
  for (int ph = 0; ph <= 11; ++ph) hipLaunchKernelGGL(fwd_kernel, dim3(grid_blocks), dim3(NT), 0, stream, p, ph, ph);
#else
  int lo = 0, hi = 11;
  (void)hipMemsetAsync((char*)d_ws + WS_BAR, 0, XCD_BAR_WORDS * 4, stream);
  void* args[] = {&p, &lo, &hi};
  hipError_t e = hipLaunchCooperativeKernel((void*)fwd_kernel, dim3(grid_blocks), dim3(NT), args, 0, stream);
  if (e != hipSuccess) fprintf(stderr, "cooperative launch failed: %s (grid %d)\n", hipGetErrorString(e), grid_blocks);
#endif
}
```

```cpp
#include <hip/hip_runtime.h>
#include <hip/hip_cooperative_groups.h>
#include <cstdio>
namespace cg = cooperative_groups;

typedef __attribute__((ext_vector_type(8))) short bf16x8;
typedef __attribute__((ext_vector_type(16))) float f32x16;
#define DI __device__ __forceinline__
#define MFMA(a, b, c) __builtin_amdgcn_mfma_f32_32x32x16_bf16((a), (b), (c), 0, 0, 0)

#define NB 8
#define SEQ 4096
#define CTX 256
#define LK 4352
#define DM 1024
#define NROWS_ALL 34816
#define NROWS_X 32768
#define INC 2304
#define EPS 1e-6f
#define NT 512
#define NW 8

#define WS_MOD   0ull
#define WS_ROPE  (WS_MOD + 221184ull)
#define WS_LAM   (WS_ROPE + 8192ull)
#define WS_WIN   (WS_LAM + 256ull)
#define WS_WOUT  (WS_WIN + 4718592ull)
#define WS_WQ    (WS_WOUT + 2097152ull)
#define WS_SK    (WS_WQ + 4194304ull)
#define WS_U     (WS_SK + 524288ull)
#define WS_V     (WS_U + 33554432ull)
#define WS_HN    (WS_V + 33554432ull)
#define WS_QD    (WS_HN + 71303168ull)
#define WS_QG    (WS_QD + 33554432ull)
#define WS_KD    (WS_QG + 33554432ull)
#define WS_KG    (WS_KD + 35651584ull)
#define WS_VDT   (WS_KG + 8912896ull)
#define WS_VGT   (WS_VDT + 35651584ull)
#define WS_OMIX  (WS_VGT + 8912896ull)
#define WS_END   (WS_OMIX + 67108864ull)
#define WS_SU    (WS_U + 16777216ull)
#define WS_SV    (WS_V + 16777216ull)
#define WS_IDS   WS_QG
#define WS_GW    (WS_QG + 8388608ull)
#define WS_PD    WS_KD
#define WS_PS    (WS_PD + 134217728ull)

struct Params {
  const float *x, *c, *ctx, *c_ctx, *w_mod, *b_mod, *n1g, *n2g, *w_in, *w_out;
  const float *lq1, *lk1, *lq2, *lk2, *subln, *gqn, *gkn, *wq, *sk, *u, *v, *fng;
  float* out;
  char* ws;
};

DI unsigned f2bf(float x) { unsigned u = __float_as_uint(x); u += 0x7fffu + ((u >> 16) & 1u); return u >> 16; }
typedef __attribute__((ext_vector_type(2))) __bf16 bf16x2_t;
typedef __attribute__((ext_vector_type(2))) float f32x2_t;
DI unsigned pack2(float lo, float hi) { f32x2_t v = {lo, hi}; bf16x2_t b = __builtin_convertvector(v, bf16x2_t); return __builtin_bit_cast(unsigned, b); }
DI float bflo(unsigned p) { return __uint_as_float(p << 16); }
DI float bfhi(unsigned p) { return __uint_as_float(p & 0xffff0000u); }
DI int crow(int i, int h) { return (i & 3) + 8 * (i >> 2) + 4 * h; }
DI float wave_sum(float v) {
#pragma unroll
  for (int o = 32; o > 0; o >>= 1) v += __shfl_xor(v, o);
  return v;
}
DI bf16x8 pack8(float a0, float a1, float a2, float a3, float a4, float a5, float a6, float a7) {
  uint4 p; p.x = pack2(a0, a1); p.y = pack2(a2, a3); p.z = pack2(a4, a5); p.w = pack2(a6, a7);
  return __builtin_bit_cast(bf16x8, p);
}

#define GLD 72
DI void gemm_mainloop(const short* __restrict__ gA, const short* __restrict__ gB, short* lds, f32x16 (&acc)[2][2]) {
  const int tid = threadIdx.x, lane = tid & 63, wave = tid >> 6, wa = wave >> 1, wb = wave & 1;
  short* sA = lds; short* sB = lds + 2 * 128 * GLD;
  const int lrow = tid >> 3, lch = tid & 7;
  uint4 ra0, ra1, ra2, ra3, rb0, rb1, rb2, rb3;
#pragma unroll
  for (int i = 0; i < 2; ++i)
#pragma unroll
    for (int j = 0; j < 2; ++j)
#pragma unroll
      for (int r = 0; r < 16; ++r) acc[i][j][r] = 0.f;
  const short* pA = gA + (size_t)lrow * DM + lch * 8;
  const short* pB = gB + (size_t)lrow * DM + lch * 8;
#define G_LOAD(K0) { ra0 = *(const uint4*)(pA + (K0)); ra1 = *(const uint4*)(pA + (size_t)32 * DM + (K0)); ra2 = *(const uint4*)(pA + (size_t)64 * DM + (K0)); ra3 = *(const uint4*)(pA + (size_t)96 * DM + (K0)); \
                 rb0 = *(const uint4*)(pB + (K0)); rb1 = *(const uint4*)(pB + (size_t)32 * DM + (K0)); rb2 = *(const uint4*)(pB + (size_t)64 * DM + (K0)); rb3 = *(const uint4*)(pB + (size_t)96 * DM + (K0)); }
#define G_STORE(DA, DB) { short* da_ = (DA) + lrow * GLD + lch * 8; short* db_ = (DB) + lrow * GLD + lch * 8; \
                 *(uint4*)(da_) = ra0; *(uint4*)(da_ + 32 * GLD) = ra1; *(uint4*)(da_ + 64 * GLD) = ra2; *(uint4*)(da_ + 96 * GLD) = ra3; \
                 *(uint4*)(db_) = rb0; *(uint4*)(db_ + 32 * GLD) = rb1; *(uint4*)(db_ + 64 * GLD) = rb2; *(uint4*)(db_ + 96 * GLD) = rb3; }
  G_LOAD(0)
  G_STORE(sA, sB)
  __syncthreads();
  const int fr = lane & 31, h = lane >> 5;
  G_LOAD(64)
  for (int kt = 0; kt < 16; ++kt) {
    const int buf = kt & 1;
    const short* fa = sA + buf * 128 * GLD + (64 * wa + fr) * GLD + h * 8;
    const short* fb = sB + buf * 128 * GLD + (64 * wb + fr) * GLD + h * 8;
#pragma unroll
    for (int s = 0; s < 4; ++s) {
      bf16x8 a0 = *(const bf16x8*)(fa + s * 16), a1 = *(const bf16x8*)(fa + 32 * GLD + s * 16);
      bf16x8 b0 = *(const bf16x8*)(fb + s * 16), b1 = *(const bf16x8*)(fb + 32 * GLD + s * 16);
      acc[0][0] = MFMA(a0, b0, acc[0][0]); acc[0][1] = MFMA(a0, b1, acc[0][1]);
      acc[1][0] = MFMA(a1, b0, acc[1][0]); acc[1][1] = MFMA(a1, b1, acc[1][1]);
    }
    G_STORE(sA + (buf ^ 1) * 128 * GLD, sB + (buf ^ 1) * 128 * GLD)
    __syncthreads();
    const int k0 = (kt < 14 ? kt + 2 : 15) * 64;
    G_LOAD(k0)
  }
#undef G_LOAD
#undef G_STORE
}

DI void gemm_mainloop_d2(const short* __restrict__ gA, const short* __restrict__ gB, short* lds, f32x16 (&acc)[2][2]) {
  const int tid = threadIdx.x, lane = tid & 63, wave = tid >> 6, wa = wave >> 1, wb = wave & 1;
  short* sA = lds; short* sB = lds + 2 * 128 * GLD;
  const int lrow = tid >> 3, lch = tid & 7;
  uint4 xa0, xa1, xa2, xa3, xb0, xb1, xb2, xb3, ya0, ya1, ya2, ya3, yb0, yb1, yb2, yb3;
#pragma unroll
  for (int i = 0; i < 2; ++i)
#pragma unroll
    for (int j = 0; j < 2; ++j)
#pragma unroll
      for (int r = 0; r < 16; ++r) acc[i][j][r] = 0.f;
  const short* pA = gA + (size_t)lrow * DM + lch * 8;
  const short* pB = gB + (size_t)lrow * DM + lch * 8;
#define G_LOAD(P, K0) { P##a0 = *(const uint4*)(pA + (K0)); P##a1 = *(const uint4*)(pA + (size_t)32 * DM + (K0)); P##a2 = *(const uint4*)(pA + (size_t)64 * DM + (K0)); P##a3 = *(const uint4*)(pA + (size_t)96 * DM + (K0)); \
                 P##b0 = *(const uint4*)(pB + (K0)); P##b1 = *(const uint4*)(pB + (size_t)32 * DM + (K0)); P##b2 = *(const uint4*)(pB + (size_t)64 * DM + (K0)); P##b3 = *(const uint4*)(pB + (size_t)96 * DM + (K0)); }
#define G_STORE(P, DA, DB) { short* da_ = (DA) + lrow * GLD + lch * 8; short* db_ = (DB) + lrow * GLD + lch * 8; \
                 *(uint4*)(da_) = P##a0; *(uint4*)(da_ + 32 * GLD) = P##a1; *(uint4*)(da_ + 64 * GLD) = P##a2; *(uint4*)(da_ + 96 * GLD) = P##a3; \
                 *(uint4*)(db_) = P##b0; *(uint4*)(db_ + 32 * GLD) = P##b1; *(uint4*)(db_ + 64 * GLD) = P##b2; *(uint4*)(db_ + 96 * GLD) = P##b3; }
#define G_COMPUTE(BUF) { const short* fa = sA + (BUF) * 128 * GLD + (64 * wa + fr) * GLD + h * 8; const short* fb = sB + (BUF) * 128 * GLD + (64 * wb + fr) * GLD + h * 8; \
    _Pragma("unroll") for (int s = 0; s < 4; ++s) { \
      bf16x8 a0 = *(const bf16x8*)(fa + s * 16), a1 = *(const bf16x8*)(fa + 32 * GLD + s * 16); \
      bf16x8 b0 = *(const bf16x8*)(fb + s * 16), b1 = *(const bf16x8*)(fb + 32 * GLD + s * 16); \
      acc[0][0] = MFMA(a0, b0, acc[0][0]); acc[0][1] = MFMA(a0, b1, acc[0][1]); \
      acc[1][0] = MFMA(a1, b0, acc[1][0]); acc[1][1] = MFMA(a1, b1, acc[1][1]); } }
  G_LOAD(x, 0)
  G_STORE(x, sA, sB)
  __syncthreads();
  const int fr = lane & 31, h = lane >> 5;
  G_LOAD(x, 64)
  G_LOAD(y, 128)
  for (int kt = 0; kt < 16; kt += 2) {
    G_COMPUTE(0)
    G_STORE(x, sA + 128 * GLD, sB + 128 * GLD)
    __syncthreads();
    { const int k0 = (kt + 3 < 16 ? kt + 3 : 15) * 64; G_LOAD(x, k0) }
    G_COMPUTE(1)
    G_STORE(y, sA, sB)
    __syncthreads();
    { const int k0 = (kt + 4 < 16 ? kt + 4 : 15) * 64; G_LOAD(y, k0) }
  }
#undef G_LOAD
#undef G_STORE
#undef G_COMPUTE
}

template <int NWA, int NWB>
DI void gemm_ml8(const short* __restrict__ gA, const short* __restrict__ gB, short* lds, f32x16 (&acc)[2][2]) {
  constexpr int RA = 64 * NWA, STG = 384 * GLD;
  const int tid = threadIdx.x, lane = tid & 63, wave = tid >> 6, wa = wave / NWB, wb = wave % NWB;
  const int lrow = tid >> 3, lch = tid & 7;
  uint4 x0, x1, x2, x3, x4, x5, y0, y1, y2, y3, y4, y5;
#pragma unroll
  for (int i = 0; i < 2; ++i)
#pragma unroll
    for (int j = 0; j < 2; ++j)
#pragma unroll
      for (int r = 0; r < 16; ++r) acc[i][j][r] = 0.f;
#define GPTR(R) (((R) * 64 < RA) ? gA + (size_t)(lrow + (R) * 64) * DM + lch * 8 : gB + (size_t)(lrow + (R) * 64 - RA) * DM + lch * 8)
#define G_LOAD(P, K0) { P##0 = *(const uint4*)(GPTR(0) + (K0)); P##1 = *(const uint4*)(GPTR(1) + (K0)); P##2 = *(const uint4*)(GPTR(2) + (K0)); \
                 P##3 = *(const uint4*)(GPTR(3) + (K0)); P##4 = *(const uint4*)(GPTR(4) + (K0)); P##5 = *(const uint4*)(GPTR(5) + (K0)); }
#define G_STORE(P, BUF) { short* d_ = lds + (BUF) * STG + lrow * GLD + lch * 8; \
                 *(uint4*)(d_) = P##0; *(uint4*)(d_ + 64 * GLD) = P##1; *(uint4*)(d_ + 128 * GLD) = P##2; *(uint4*)(d_ + 192 * GLD) = P##3; *(uint4*)(d_ + 256 * GLD) = P##4; *(uint4*)(d_ + 320 * GLD) = P##5; }
#define G_COMPUTE(BUF) { const short* fa = lds + (BUF) * STG + (64 * wa + fr) * GLD + h * 8; const short* fb = lds + (BUF) * STG + (RA + 64 * wb + fr) * GLD + h * 8; \
    _Pragma("unroll") for (int s = 0; s < 4; ++s) { \
      bf16x8 a0 = *(const bf16x8*)(fa + s * 16), a1 = *(const bf16x8*)(fa + 32 * GLD + s * 16); \
      bf16x8 b0 = *(const bf16x8*)(fb + s * 16), b1 = *(const bf16x8*)(fb + 32 * GLD + s * 16); \
      acc[0][0] = MFMA(a0, b0, acc[0][0]); acc[0][1] = MFMA(a0, b1, acc[0][1]); \
      acc[1][0] = MFMA(a1, b0, acc[1][0]); acc[1][1] = MFMA(a1, b1, acc[1][1]); } }
  G_LOAD(x, 0)
  G_STORE(x, 0)
  __syncthreads();
  const int fr = lane & 31, h = lane >> 5;
  G_LOAD(x, 64)
  G_LOAD(y, 128)
  for (int kt = 0; kt < 16; kt += 2) {
    G_COMPUTE(0)
    G_STORE(x, 1)
    __syncthreads();
    { const int k0 = (kt + 3 < 16 ? kt + 3 : 15) * 64; G_LOAD(x, k0) }
    G_COMPUTE(1)
    G_STORE(y, 0)
    __syncthreads();
    { const int k0 = (kt + 4 < 16 ? kt + 4 : 15) * 64; G_LOAD(y, k0) }
  }
#undef GPTR
#undef G_LOAD
#undef G_STORE
#undef G_COMPUTE
}

#define P0_MOD 192
#define P0_TR  1344
#define P0_CV  (32 + 8192)
#define P0_ITEMS (P0_MOD + P0_TR + P0_CV + 1)
DI float silu(float v) { return v / (1.f + __expf(-v)); }

DI void phase0(const Params& p, float* ldsf) {
  const int tid = threadIdx.x & 255, sb = threadIdx.x >> 8;
  ldsf += sb * 11520;
  for (int it0 = 2 * blockIdx.x; it0 < P0_ITEMS; it0 += 2 * gridDim.x) {
    const int it = it0 + sb;
    if (it >= P0_ITEMS) continue;
    if (it < P0_MOD) {
      for (int e = tid; e < 9 * 1024; e += 256) { float v = e < 8192 ? p.c[e] : p.c_ctx[e - 8192]; ldsf[e] = silu(v); }
      __syncthreads();
      const int col = tid & 31, kg = tid >> 5, n = it * 32 + col;
      float a[9];
#pragma unroll
      for (int r = 0; r < 9; ++r) a[r] = 0.f;
      for (int k = kg * 128; k < kg * 128 + 128; k += 16) {
        float w[16];
#pragma unroll
        for (int u = 0; u < 16; ++u) w[u] = p.w_mod[(size_t)(k + u) * 6144 + n];
#pragma unroll
        for (int u = 0; u < 16; ++u)
#pragma unroll
          for (int r = 0; r < 9; ++r) a[r] += ldsf[r * 1024 + k + u] * w[u];
      }
      float* red = ldsf + 9216;
#pragma unroll
      for (int r = 0; r < 9; ++r) red[(kg * 9 + r) * 32 + col] = a[r];
      __syncthreads();
      for (int idx = tid; idx < 288; idx += 256) {
        const int r = idx >> 5, cc = idx & 31; float s = 0.f;
#pragma unroll
        for (int g = 0; g < 8; ++g) s += red[(g * 9 + r) * 32 + cc];
        ((float*)(p.ws + WS_MOD))[r * 6144 + it * 32 + cc] = s + p.b_mod[it * 32 + cc];
      }
      __syncthreads();
    } else if (it < P0_MOD + P0_TR) {
      int t = it - P0_MOD; const float* src; unsigned short* dst; int N, nt_cnt;
      if (t < 576) { src = p.w_in; dst = (unsigned short*)(p.ws + WS_WIN); N = 2304; nt_cnt = 36; }
      else if (t < 832) { t -= 576; src = p.w_out; dst = (unsigned short*)(p.ws + WS_WOUT); N = 1024; nt_cnt = 16; }
      else { t -= 832; src = p.wq; dst = (unsigned short*)(p.ws + WS_WQ); N = 2048; nt_cnt = 32; }
      const int kt = t / nt_cnt, nt = t % nt_cnt;
      const int cc = tid & 63, r0 = tid >> 6;
#pragma unroll
      for (int j = 0; j < 16; ++j) { int r = r0 + 4 * j; ldsf[r * 65 + cc] = src[(size_t)(kt * 64 + r) * N + nt * 64 + cc]; }
      __syncthreads();
#pragma unroll
      for (int j = 0; j < 16; ++j) { int n = r0 + 4 * j; dst[(size_t)(nt * 64 + n) * 1024 + kt * 64 + cc] = (unsigned short)f2bf(ldsf[cc * 65 + n]); }
      __syncthreads();
    } else if (it < P0_MOD + P0_TR + 32) {
      const int t = it - P0_MOD - P0_TR; const float* src = p.sk; char* dst = p.ws + WS_SK;
#pragma unroll
      for (int j = 0; j < 4; ++j) {
        size_t idx = (size_t)t * 8192 + j * 2048 + tid * 8;
        float4 a = *(const float4*)(src + idx), b = *(const float4*)(src + idx + 4);
        uint4 o; o.x = pack2(a.x, a.y); o.y = pack2(a.z, a.w); o.z = pack2(b.x, b.y); o.w = pack2(b.z, b.w);
        *(uint4*)(dst + idx * 2) = o;
      }
    } else if (it < P0_MOD + P0_TR + P0_CV) {
      int t = it - P0_MOD - P0_TR - 32;
      const bool isv = t >= 4096; t &= 4095;
      const float* src = isv ? p.v : p.u;
      char* dst = p.ws + (isv ? WS_V : WS_U);
      float* sc = (float*)(p.ws + (isv ? WS_SV : WS_SU));
      const int lane = tid & 63, row = t * 4 + (tid >> 6);
      const float4* s4 = (const float4*)(src + (size_t)row * 1024);
      float4 q[4]; float am = 0.f;
#pragma unroll
      for (int j = 0; j < 4; ++j) { q[j] = s4[lane + 64 * j]; am = fmaxf(am, fmaxf(fmaxf(fabsf(q[j].x), fabsf(q[j].y)), fmaxf(fabsf(q[j].z), fabsf(q[j].w)))); }
#pragma unroll
      for (int o = 32; o > 0; o >>= 1) am = fmaxf(am, __shfl_xor(am, o));
      const float scl = am > 0.f ? 384.f / am : 1.f;
      uint4 o;
      unsigned* ow = (unsigned*)&o;
#pragma unroll
      for (int j = 0; j < 4; ++j) {
        int w = 0;
        w = __builtin_amdgcn_cvt_pk_fp8_f32(q[j].x * scl, q[j].y * scl, w, false);
        w = __builtin_amdgcn_cvt_pk_fp8_f32(q[j].z * scl, q[j].w * scl, w, true);
        ow[j] = (unsigned)w;
      }
#pragma unroll
      for (int j = 0; j < 4; ++j) ((unsigned*)(dst + (size_t)row * 1024))[lane + 64 * j] = ow[j];
      if (lane == 0) sc[row] = am > 0.f ? am / 384.f : 1.f;
    } else {
      float2* rt = (float2*)(p.ws + WS_ROPE);
      for (int e = tid; e < 1024; e += 256) {
        const int pos = e >> 4, fi = e & 15;
        float freq = powf(10000.f, -(float)fi / 16.f);
        float ang = (float)pos * freq;
        rt[e] = make_float2(cosf(ang), sinf(ang));
      }
      if (tid == 0) {
        float s1 = 0.f, s2 = 0.f;
        for (int i = 0; i < 64; ++i) { s1 += p.lq1[i] * p.lk1[i]; s2 += p.lq2[i] * p.lk2[i]; }
        *(float*)(p.ws + WS_LAM) = expf(s1) - expf(s2) + 0.2f;
      }
    }
  }
}

DI void prep_row(const float* __restrict__ src, const float* __restrict__ g, const float* __restrict__ sh, const float* __restrict__ sc, short* __restrict__ dst) {
  const int lane = threadIdx.x & 63;
  float4 v[4]; float ss = 0.f;
#pragma unroll
  for (int j = 0; j < 4; ++j) { v[j] = *(const float4*)(src + 4 * (lane + 64 * j)); ss += v[j].x * v[j].x + v[j].y * v[j].y + v[j].z * v[j].z + v[j].w * v[j].w; }
  ss = wave_sum(ss);
  const float rinv = rsqrtf(ss * (1.f / 1024.f) + EPS);
#pragma unroll
  for (int j = 0; j < 4; ++j) {
    const int d = 4 * (lane + 64 * j);
    float4 gg = *(const float4*)(g + d), s1 = *(const float4*)(sc + d), s0 = *(const float4*)(sh + d);
    float y0 = v[j].x * rinv * gg.x * (1.f + s1.x) + s0.x;
    float y1 = v[j].y * rinv * gg.y * (1.f + s1.y) + s0.y;
    float y2 = v[j].z * rinv * gg.z * (1.f + s1.z) + s0.z;
    float y3 = v[j].w * rinv * gg.w * (1.f + s1.w) + s0.w;
    uint2 o; o.x = pack2(y0, y1); o.y = pack2(y2, y3);
    *(uint2*)(dst + d) = o;
  }
}
DI void phase1(const Params& p) {
  const int wave = threadIdx.x >> 6;
  const float* mod = (const float*)(p.ws + WS_MOD);
  for (int g = blockIdx.x; g < NROWS_ALL / NW; g += gridDim.x) {
    const int r = g * NW + wave, b = r / LK, t = r % LK;
    const float* src = t < CTX ? p.ctx + ((size_t)b * CTX + t) * DM : p.x + ((size_t)b * SEQ + t - CTX) * DM;
    const float* m = mod + (t < CTX ? 8 : b) * 6144;
    prep_row(src, p.n1g, m, m + 1024, (short*)(p.ws + WS_HN) + (size_t)r * DM);
  }
}
DI void phase5(const Params& p) {
  const int wave = threadIdx.x >> 6;
  const float* mod = (const float*)(p.ws + WS_MOD);
  for (int g = blockIdx.x; g < NROWS_X / NW; g += gridDim.x) {
    const int r = g * NW + wave, b = r / SEQ;
    const float* m = mod + b * 6144;
    prep_row(p.out + (size_t)r * DM, p.n2g, m + 3072, m + 4096, (short*)(p.ws + WS_HN) + (size_t)r * DM);
  }
}

DI void phase2(const Params& p, short* lds) {
  const int tid = threadIdx.x, lane = tid & 63, wave = tid >> 6, fr = lane & 31, h = lane >> 5;
  const short* HN = (const short*)(p.ws + WS_HN);
  const short* WIN = (const short*)(p.ws + WS_WIN);
  const float2* rope = (const float2*)(p.ws + WS_ROPE);
  const int xcd = blockIdx.x & 7, slot = blockIdx.x >> 3, nslots = gridDim.x >> 3;
  for (int lt = slot; lt < 17 * 18; lt += nslots) {
    const int ct = lt % 18, rt = xcd + 8 * (lt / 18);
    const int b = rt / 17, trow = (rt % 17) * 256;
    const bool isctx = trow < CTX;
    const bool qtype = (ct < 4) || (ct >= 12 && ct < 16);
    if (isctx && qtype) continue;
    const bool vtype = (ct >= 8 && ct < 12) || ct == 17;
    f32x16 acc[2][2];
    const short* gTok = HN + (size_t)rt * 256 * DM;
    const short* gW = WIN + (size_t)ct * 128 * DM;
    if (vtype) {
      const int wa = wave >> 1, wb = wave & 1;
      gemm_ml8<4, 2>(gTok, gW, lds, acc);
#pragma unroll
      for (int tb = 0; tb < 2; ++tb)
#pragma unroll
        for (int ta = 0; ta < 2; ++ta)
#pragma unroll
          for (int A = 0; A < 2; ++A) {
            const f32x16& c = acc[ta][tb];
            *(bf16x8*)(lds + (64 * wb + 32 * tb + fr) * 264 + 64 * wa + 32 * ta + 16 * A + 8 * h) =
                pack8(c[8 * A], c[8 * A + 1], c[8 * A + 2], c[8 * A + 3], c[8 * A + 4], c[8 * A + 5], c[8 * A + 6], c[8 * A + 7]);
          }
      __syncthreads();
      {
        const int c32 = tid & 31;
#pragma unroll
        for (int it = 0; it < 8; ++it) {
          const int f = (tid >> 5) + 16 * it;
          short* rowp;
          if (ct == 17) rowp = (short*)(p.ws + WS_VGT) + ((size_t)(b * 2 + (f >> 6)) * 64 + (f & 63)) * LK;
          else rowp = (short*)(p.ws + WS_VDT) + ((size_t)(b * 4 + (ct - 8)) * 128 + f) * LK;
          *(uint4*)(rowp + trow + c32 * 8) = *(const uint4*)(lds + f * 264 + c32 * 8);
        }
      }
      __syncthreads();
    } else {
      const int wa = wave >> 2, wb = wave & 3;
      gemm_ml8<2, 4>(gW, gTok, lds, acc);
      const bool norm = ct >= 12;
      const float* gn = (ct == 16) ? p.gkn : p.gqn;
#pragma unroll
      for (int tb = 0; tb < 2; ++tb) {
        const int t = trow + 64 * wb + 32 * tb + fr;
        const int s = t - CTX;
        float v[2][16];
#pragma unroll
        for (int ta = 0; ta < 2; ++ta)
#pragma unroll
          for (int i = 0; i < 16; ++i) v[ta][i] = acc[ta][tb][i];
        if (norm) {
          float ss = 0.f;
#pragma unroll
          for (int ta = 0; ta < 2; ++ta)
#pragma unroll
            for (int i = 0; i < 16; ++i) ss += v[ta][i] * v[ta][i];
          ss += __shfl_xor(ss, 32);
          const float rinv = rsqrtf(ss * (1.f / 64.f) + EPS);
#pragma unroll
          for (int ta = 0; ta < 2; ++ta)
#pragma unroll
            for (int i = 0; i < 16; ++i) v[ta][i] *= rinv * gn[32 * ta + crow(i, h)];
        }
        if (!isctx) {
          const int pr = s >> 6, pc = s & 63;
#pragma unroll
          for (int ta = 0; ta < 2; ++ta) {
            const int pos = ta ? pc : pr;
#pragma unroll
            for (int i = 0; i < 8; ++i) {
              const float2 cs = rope[pos * 16 + crow(i, h)];
              const float x1 = v[ta][i], x2 = v[ta][i + 8];
              v[ta][i] = x1 * cs.x - x2 * cs.y;
              v[ta][i + 8] = x1 * cs.y + x2 * cs.x;
            }
          }
        }
        short* srow = lds + (64 * wb + 32 * tb + fr) * 136 + 64 * wa;
#pragma unroll
        for (int ta = 0; ta < 2; ++ta)
#pragma unroll
          for (int g = 0; g < 4; ++g) {
            uint2 o; o.x = pack2(v[ta][4 * g], v[ta][4 * g + 1]); o.y = pack2(v[ta][4 * g + 2], v[ta][4 * g + 3]);
            *(uint2*)(srow + 32 * ta + 8 * g + 4 * h) = o;
          }
      }
      __syncthreads();
      {
        const int c8 = tid & 7;
#pragma unroll
        for (int it = 0; it < 8; ++it) {
          const int rowid = (tid >> 3) + 64 * it, tl = rowid & 255, hsel = rowid >> 8;
          const int t = trow + tl, s = t - CTX;
          short* dst;
          if (ct < 4)       dst = (short*)(p.ws + WS_QD) + ((size_t)(b * 8 + ct * 2 + hsel) * SEQ + s) * 64;
          else if (ct < 8)  dst = (short*)(p.ws + WS_KD) + ((size_t)(b * 8 + (ct - 4) * 2 + hsel) * LK + t) * 64;
          else if (ct < 16) dst = (short*)(p.ws + WS_QG) + ((size_t)(b * 8 + (ct - 12) * 2 + hsel) * SEQ + s) * 64;
          else              dst = (short*)(p.ws + WS_KG) + ((size_t)(b * 2 + hsel) * LK + t) * 64;
          *(uint4*)(dst + c8 * 8) = *(const uint4*)(lds + tl * 136 + hsel * 64 + c8 * 8);
        }
      }
      __syncthreads();
    }
  }
}

DI float xhalf_max(float v) { float a = v, b = v; asm volatile("s_nop 1\n\tv_permlane32_swap_b32 %0, %1\n\ts_nop 1" : "+v"(a), "+v"(b)); return fmaxf(a, b); }
#define ALD 72
#define SM_C 0.18033688011112042f
#define SM_THR 8.0f
template <int DV>
DI void attn_run(const short* __restrict__ Qp, const short* __restrict__ Kp, const short* __restrict__ Vtp, short* lds, f32x16 (&O)[DV / 32]) {
  constexpr int NDV = DV / 32;
  const int tid = threadIdx.x, lane = tid & 63, wave = tid >> 6, fr = lane & 31, h = lane >> 5;
  bf16x8 qf[4];
#pragma unroll
  for (int s = 0; s < 4; ++s) qf[s] = *(const bf16x8*)(Qp + (size_t)(wave * 32 + fr) * 64 + s * 16 + h * 8);
#pragma unroll
  for (int d = 0; d < NDV; ++d)
#pragma unroll
    for (int i = 0; i < 16; ++i) O[d][i] = 0.f;
  float m = -1e30f, lsum = 0.f;
  const int lrow = tid >> 3, lch = tid & 7;
  uint4 kr0, vr0, vr1;
  const short* pK = Kp + (size_t)lrow * 64 + lch * 8;
  const short* pV = Vtp + (size_t)lrow * LK + lch * 8;
  short* const ldsV = lds + 2 * 64 * ALD;
#define K_LOAD(K0) { kr0 = *(const uint4*)(pK + (size_t)(K0) * 64); }
#define V_LOAD(K0) { vr0 = *(const uint4*)(pV + (K0)); vr1 = *(const uint4*)(pV + (size_t)64 * LK + (K0)); }
#define K_STORE(SLOT) { *(uint4*)(lds + (SLOT) * 64 * ALD + lrow * ALD + lch * 8) = kr0; }
#define V_STORE(SLOT) { short* dv_ = ldsV + (SLOT) * 128 * ALD + lrow * ALD + lch * 8; *(uint4*)(dv_) = vr0; *(uint4*)(dv_ + 64 * ALD) = vr1; }
  auto qk = [&](int slot, f32x16 (&S)[2]) __attribute__((always_inline)) {
    const short* sK = lds + slot * 64 * ALD;
#pragma unroll
    for (int j = 0; j < 2; ++j) {
      bf16x8 kf[4];
#pragma unroll
      for (int s = 0; s < 4; ++s) kf[s] = *(const bf16x8*)(sK + (32 * j + fr) * ALD + s * 16 + h * 8);
#pragma unroll
      for (int i = 0; i < 16; ++i) S[j][i] = 0.f;
#pragma unroll
      for (int s = 0; s < 4; ++s) S[j] = MFMA(kf[s], qf[s], S[j]);
    }
  };
  auto step = [&](int kt, f32x16 (&Sc)[2], f32x16 (&Sn)[2]) __attribute__((always_inline)) {
    qk((kt + 1) & 1, Sn);
    float mx = Sc[0][0];
#pragma unroll
    for (int i = 1; i < 16; ++i) mx = fmaxf(mx, Sc[0][i]);
#pragma unroll
    for (int i = 0; i < 16; ++i) mx = fmaxf(mx, Sc[1][i]);
    mx = xhalf_max(mx);
    const float mc = mx * SM_C;
    if (__any(mc > m + SM_THR)) {
      const float mn = fmaxf(m, mc);
      const float alpha = __builtin_amdgcn_exp2f(m - mn);
      m = mn; lsum *= alpha;
#pragma unroll
      for (int d = 0; d < NDV; ++d)
#pragma unroll
        for (int i = 0; i < 16; ++i) O[d][i] *= alpha;
    }
#pragma unroll
    for (int j = 0; j < 2; ++j)
#pragma unroll
      for (int i = 0; i < 16; ++i) { float pv = __builtin_amdgcn_exp2f(Sc[j][i] * SM_C - m); Sc[j][i] = pv; lsum += pv; }
    bf16x8 pf[2][2];
#pragma unroll
    for (int j = 0; j < 2; ++j)
#pragma unroll
      for (int s = 0; s < 2; ++s)
        pf[j][s] = pack8(Sc[j][8 * s], Sc[j][8 * s + 1], Sc[j][8 * s + 2], Sc[j][8 * s + 3], Sc[j][8 * s + 4], Sc[j][8 * s + 5], Sc[j][8 * s + 6], Sc[j][8 * s + 7]);
    const short* sV = ldsV + (kt & 1) * 128 * ALD;
#pragma unroll
    for (int d = 0; d < NDV; ++d) {
      bf16x8 vf[2][2];
#pragma unroll
      for (int j = 0; j < 2; ++j)
#pragma unroll
        for (int s = 0; s < 2; ++s) vf[j][s] = *(const bf16x8*)(sV + (32 * d + fr) * ALD + 32 * j + 16 * s + 8 * h);
#pragma unroll
      for (int j = 0; j < 2; ++j)
#pragma unroll
        for (int s = 0; s < 2; ++s) O[d] = MFMA(vf[j][s], pf[j][s], O[d]);
    }
    K_STORE(kt & 1)
    V_STORE((kt + 1) & 1)
    __syncthreads();
    const int kn = (kt < 65 ? kt + 3 : 67) * 64, vn = (kt < 66 ? kt + 2 : 67) * 64;
    K_LOAD(kn)
    V_LOAD(vn)
  };
  K_LOAD(0) V_LOAD(0)
  K_STORE(0) V_STORE(0)
  K_LOAD(64)
  K_STORE(1)
  __syncthreads();
  f32x16 Sa[2], Sb[2];
  qk(0, Sa);
  __syncthreads();
  K_LOAD(128) V_LOAD(64)
  for (int kt = 0; kt < 68; kt += 2) { step(kt, Sa, Sb); step(kt + 1, Sb, Sa); }
#undef K_LOAD
#undef V_LOAD
#undef K_STORE
#undef V_STORE
  lsum += __shfl_xor(lsum, 32);
  const float inv = 1.f / lsum;
#pragma unroll
  for (int d = 0; d < NDV; ++d)
#pragma unroll
    for (int i = 0; i < 16; ++i) O[d][i] *= inv;
}

DI void attn_diff_item(const Params& p, short* lds, int b, int hd, int qb) {
  const int lane = threadIdx.x & 63, wave = threadIdx.x >> 6, fr = lane & 31, h = lane >> 5;
  const short* Vt = (const short*)(p.ws + WS_VDT) + (size_t)(b * 4 + hd) * 128 * LK;
  short* rowp = (short*)(p.ws + WS_OMIX) + ((size_t)b * SEQ + qb * 256 + wave * 32 + fr) * DM + hd * 128;
  {
    f32x16 O[4];
    attn_run<128>((const short*)(p.ws + WS_QD) + ((size_t)(b * 8 + hd * 2) * SEQ + qb * 256) * 64,
                  (const short*)(p.ws + WS_KD) + (size_t)(b * 8 + hd * 2) * LK * 64, Vt, lds, O);
#pragma unroll
    for (int d = 0; d < 4; ++d)
#pragma unroll
      for (int g = 0; g < 4; ++g) {
        uint2 o; o.x = pack2(O[d][4 * g], O[d][4 * g + 1]); o.y = pack2(O[d][4 * g + 2], O[d][4 * g + 3]);
        *(uint2*)(rowp + 32 * d + 8 * g + 4 * h) = o;
      }
  }
  f32x16 O[4];
  attn_run<128>((const short*)(p.ws + WS_QD) + ((size_t)(b * 8 + hd * 2 + 1) * SEQ + qb * 256) * 64,
                (const short*)(p.ws + WS_KD) + (size_t)(b * 8 + hd * 2 + 1) * LK * 64, Vt, lds, O);
  const float lam = *(const float*)(p.ws + WS_LAM);
  float ss = 0.f;
#pragma unroll
  for (int d = 0; d < 4; ++d)
#pragma unroll
    for (int g = 0; g < 4; ++g) {
      const uint2 o1 = *(const uint2*)(rowp + 32 * d + 8 * g + 4 * h);
      float a0 = bflo(o1.x) - lam * O[d][4 * g], a1 = bfhi(o1.x) - lam * O[d][4 * g + 1];
      float a2 = bflo(o1.y) - lam * O[d][4 * g + 2], a3 = bfhi(o1.y) - lam * O[d][4 * g + 3];
      O[d][4 * g] = a0; O[d][4 * g + 1] = a1; O[d][4 * g + 2] = a2; O[d][4 * g + 3] = a3;
      ss += a0 * a0 + a1 * a1 + a2 * a2 + a3 * a3;
    }
  ss += __shfl_xor(ss, 32);
  const float rinv = rsqrtf(ss * (1.f / 128.f) + EPS) * 0.8f;
#pragma unroll
  for (int d = 0; d < 4; ++d)
#pragma unroll
    for (int g = 0; g < 4; ++g) {
      const int dv = 32 * d + 8 * g + 4 * h;
      const float4 sg = *(const float4*)(p.subln + dv);
      uint2 o; o.x = pack2(O[d][4 * g] * rinv * sg.x, O[d][4 * g + 1] * rinv * sg.y);
      o.y = pack2(O[d][4 * g + 2] * rinv * sg.z, O[d][4 * g + 3] * rinv * sg.w);
      *(uint2*)(rowp + dv) = o;
    }
}
DI void attn_gqa2_item(const Params& p, short* lds, int b, int kvh, int pair, int qb) {
  constexpr int BUFSZ = (64 + 128) * ALD;
  const int tid = threadIdx.x, lane = tid & 63, wave = tid >> 6, fr = lane & 31, h = lane >> 5;
  const int qh0 = kvh * 4 + pair * 2;
  const short* Qp0 = (const short*)(p.ws + WS_QG) + ((size_t)(b * 8 + qh0) * SEQ + qb * 256) * 64;
  const short* Qp1 = Qp0 + (size_t)SEQ * 64;
  const short* Kp = (const short*)(p.ws + WS_KG) + (size_t)(b * 2 + kvh) * LK * 64;
  const short* Vtp = (const short*)(p.ws + WS_VGT) + (size_t)(b * 2 + kvh) * 64 * LK;
  bf16x8 qf[2][4];
#pragma unroll
  for (int s = 0; s < 4; ++s) {
    qf[0][s] = *(const bf16x8*)(Qp0 + (size_t)(wave * 32 + fr) * 64 + s * 16 + h * 8);
    qf[1][s] = *(const bf16x8*)(Qp1 + (size_t)(wave * 32 + fr) * 64 + s * 16 + h * 8);
  }
  f32x16 O[2][2];
#pragma unroll
  for (int a = 0; a < 2; ++a)
#pragma unroll
    for (int d = 0; d < 2; ++d)
#pragma unroll
      for (int i = 0; i < 16; ++i) O[a][d][i] = 0.f;
  float m[2] = {-1e30f, -1e30f}, lsum[2] = {0.f, 0.f};
  const int lrow = tid >> 3, lch = tid & 7;
  uint4 kr0, vr0;
  const short* pK = Kp + (size_t)lrow * 64 + lch * 8;
  const short* pV = Vtp + (size_t)lrow * LK + lch * 8;
#define A_LOAD(K0) { kr0 = *(const uint4*)(pK + (size_t)(K0) * 64); vr0 = *(const uint4*)(pV + (K0)); }
#define A_STORE(DK) { short* dk_ = (DK) + lrow * ALD + lch * 8; short* dv_ = dk_ + 64 * ALD; *(uint4*)(dk_) = kr0; *(uint4*)(dv_) = vr0; }
  A_LOAD(0)
  A_STORE(lds)
  __syncthreads();
  A_LOAD(64)
  for (int kt = 0; kt < 68; ++kt) {
    const int buf = kt & 1;
    const short* sK = lds + buf * BUFSZ;
    const short* sV = sK + 64 * ALD;
    f32x16 S[2][2];
    {
      bf16x8 kf[2][4];
#pragma unroll
      for (int j = 0; j < 2; ++j)
#pragma unroll
        for (int s = 0; s < 4; ++s) kf[j][s] = *(const bf16x8*)(sK + (32 * j + fr) * ALD + s * 16 + h * 8);
#pragma unroll
      for (int a = 0; a < 2; ++a)
#pragma unroll
        for (int j = 0; j < 2; ++j)
#pragma unroll
          for (int i = 0; i < 16; ++i) S[a][j][i] = 0.f;
#pragma unroll
      for (int s = 0; s < 4; ++s)
#pragma unroll
        for (int j = 0; j < 2; ++j)
#pragma unroll
          for (int a = 0; a < 2; ++a) S[a][j] = MFMA(kf[j][s], qf[a][s], S[a][j]);
    }
    bf16x8 pf[2][2][2];
#pragma unroll
    for (int a = 0; a < 2; ++a) {
      float mx = S[a][0][0];
#pragma unroll
      for (int i = 1; i < 16; ++i) mx = fmaxf(mx, S[a][0][i]);
#pragma unroll
      for (int i = 0; i < 16; ++i) mx = fmaxf(mx, S[a][1][i]);
      mx = xhalf_max(mx);
      const float mc = mx * SM_C;
      if (__any(mc > m[a] + SM_THR)) {
        const float mn = fmaxf(m[a], mc);
        const float alpha = __builtin_amdgcn_exp2f(m[a] - mn);
        m[a] = mn; lsum[a] *= alpha;
#pragma unroll
        for (int d = 0; d < 2; ++d)
#pragma unroll
          for (int i = 0; i < 16; ++i) O[a][d][i] *= alpha;
      }
#pragma unroll
      for (int j = 0; j < 2; ++j)
#pragma unroll
        for (int i = 0; i < 16; ++i) { float pv = __builtin_amdgcn_exp2f(S[a][j][i] * SM_C - m[a]); S[a][j][i] = pv; lsum[a] += pv; }
#pragma unroll
      for (int j = 0; j < 2; ++j)
#pragma unroll
        for (int s = 0; s < 2; ++s)
          pf[a][j][s] = pack8(S[a][j][8 * s], S[a][j][8 * s + 1], S[a][j][8 * s + 2], S[a][j][8 * s + 3], S[a][j][8 * s + 4], S[a][j][8 * s + 5], S[a][j][8 * s + 6], S[a][j][8 * s + 7]);
    }
    {
      bf16x8 vf[2][2][2];
#pragma unroll
      for (int d = 0; d < 2; ++d)
#pragma unroll
        for (int j = 0; j < 2; ++j)
#pragma unroll
          for (int s = 0; s < 2; ++s) vf[d][j][s] = *(const bf16x8*)(sV + (32 * d + fr) * ALD + 32 * j + 16 * s + 8 * h);
#pragma unroll
      for (int j = 0; j < 2; ++j)
#pragma unroll
        for (int s = 0; s < 2; ++s)
#pragma unroll
          for (int d = 0; d < 2; ++d)
#pragma unroll
            for (int a = 0; a < 2; ++a) O[a][d] = MFMA(vf[d][j][s], pf[a][j][s], O[a][d]);
    }
    A_STORE(lds + (buf ^ 1) * BUFSZ)
    __syncthreads();
    const int k0n = (kt < 66 ? kt + 2 : 67) * 64;
    A_LOAD(k0n)
  }
#undef A_LOAD
#undef A_STORE
#pragma unroll
  for (int a = 0; a < 2; ++a) {
    float l = lsum[a]; l += __shfl_xor(l, 32);
    const float inv = 1.f / l;
    short* rowp = (short*)(p.ws + WS_OMIX) + ((size_t)b * SEQ + qb * 256 + wave * 32 + fr) * DM + 512 + (qh0 + a) * 64;
#pragma unroll
    for (int d = 0; d < 2; ++d)
#pragma unroll
      for (int g = 0; g < 4; ++g) {
        uint2 o; o.x = pack2(O[a][d][4 * g] * inv, O[a][d][4 * g + 1] * inv); o.y = pack2(O[a][d][4 * g + 2] * inv, O[a][d][4 * g + 3] * inv);
        *(uint2*)(rowp + 32 * d + 8 * g + 4 * h) = o;
      }
  }
}
DI void phase3(const Params& p, short* lds) {
  const int xcd = blockIdx.x & 7, slot = blockIdx.x >> 3, nslots = gridDim.x >> 3;
  for (int j = slot; j < 64; j += nslots) {
    const int grp = xcd * 4 + (j >> 4);
    attn_diff_item(p, lds, grp >> 2, grp & 3, j & 15);
  }
  for (int j = slot; j < 64; j += nslots) {
    const int sg = xcd * 2 + (j >> 5);
    attn_gqa2_item(p, lds, sg >> 1, sg & 1, (j & 31) >> 4, j & 15);
  }
}

DI void phase4(const Params& p, short* lds) {
  const int tid = threadIdx.x, lane = tid & 63, wave = tid >> 6, wa = wave >> 1, wb = wave & 1, fr = lane & 31, h = lane >> 5;
  const float* mod = (const float*)(p.ws + WS_MOD);
  float* stg = (float*)lds;
  const int xcd = blockIdx.x & 7, slot = blockIdx.x >> 3, nslots = gridDim.x >> 3;
  for (int lt = slot; lt < 16 * 8; lt += nslots) {
    const int ct = lt & 7, rt = xcd + 8 * (lt >> 3);
    f32x16 acc[2][2];
    gemm_ml8<4, 2>((const short*)(p.ws + WS_OMIX) + (size_t)rt * 256 * DM, (const short*)(p.ws + WS_WOUT) + (size_t)ct * 128 * DM, lds, acc);
    const int b = rt >> 4;
#pragma unroll
    for (int tb = 0; tb < 2; ++tb)
#pragma unroll
      for (int ta = 0; ta < 2; ++ta)
#pragma unroll
        for (int i = 0; i < 16; ++i) stg[(64 * wa + 32 * ta + crow(i, h)) * 132 + 64 * wb + 32 * tb + fr] = acc[ta][tb][i];
    __syncthreads();
    const int n4 = (tid & 31) * 4, r0 = tid >> 5;
    const float4 g1 = *(const float4*)(mod + b * 6144 + 2048 + ct * 128 + n4);
#pragma unroll 4
    for (int it = 0; it < 16; ++it) {
      const int r = r0 + 16 * it;
      const size_t gi = ((size_t)rt * 256 + r) * DM + ct * 128 + n4;
      const float4 a = *(const float4*)(stg + r * 132 + n4), xv = *(const float4*)(p.x + gi);
      *(float4*)(p.out + gi) = make_float4(xv.x + g1.x * a.x, xv.y + g1.y * a.y, xv.z + g1.z * a.z, xv.w + g1.w * a.w);
    }
    __syncthreads();
  }
}

DI void cex(int& a, int& b, bool desc) { int mx = max(a, b), mn = min(a, b); a = desc ? mx : mn; b = desc ? mn : mx; }
DI void merge16(int (&a)[16], bool desc) {
#pragma unroll
  for (int j = 8; j > 0; j >>= 1)
#pragma unroll
    for (int i = 0; i < 16; ++i) { const int l = i ^ j; if (l > i) cex(a[i], a[l], desc); }
}
#define QLD 136
DI void phase6(const Params& p, short* lds) {
  const int tid = threadIdx.x, lane = tid & 63, wave = tid >> 6, wa = wave >> 2, wb = wave & 3, fr = lane & 31, h = lane >> 5;
  short* sQ = lds; short* sK = lds + 256 * QLD;
  int* TK1 = (int*)(p.ws + WS_QD);
  const int xcd = blockIdx.x & 7, slot = blockIdx.x >> 3, nslots = gridDim.x >> 3;
  for (int lt = slot; lt < 16 * 16; lt += nslots) {
    const int hp = lt & 15, rt = xcd + 8 * (lt >> 4);
    {
      f32x16 acc[2][2];
      gemm_ml8<2, 4>((const short*)(p.ws + WS_WQ) + (size_t)hp * 128 * DM, (const short*)(p.ws + WS_HN) + (size_t)rt * 256 * DM, lds, acc);
#pragma unroll
      for (int tb = 0; tb < 2; ++tb)
#pragma unroll
        for (int ta = 0; ta < 2; ++ta)
#pragma unroll
          for (int g = 0; g < 4; ++g) {
            const f32x16& c = acc[ta][tb];
            uint2 o; o.x = pack2(c[4 * g], c[4 * g + 1]); o.y = pack2(c[4 * g + 2], c[4 * g + 3]);
            *(uint2*)(sQ + (64 * wb + 32 * tb + fr) * QLD + 64 * wa + 32 * ta + 8 * g + 4 * h) = o;
          }
    }
    {
      const short* skg = (const short*)(p.ws + WS_SK) + (size_t)hp * 128 * 128;
#pragma unroll
      for (int r = 0; r < 4; ++r) { const int c = tid + 512 * r; *(uint4*)(sK + (c >> 4) * QLD + (c & 15) * 8) = *(const uint4*)(skg + c * 8); }
    }
    __syncthreads();
    int v[64];
    {
      f32x16 sc[4];
#pragma unroll
      for (int k = 0; k < 4; ++k)
#pragma unroll
        for (int i = 0; i < 16; ++i) sc[k][i] = 0.f;
#pragma unroll
      for (int ks = 0; ks < 8; ++ks) {
        bf16x8 qf = *(const bf16x8*)(sQ + (32 * wave + fr) * QLD + ks * 16 + 8 * h);
#pragma unroll
        for (int k = 0; k < 4; ++k) {
          bf16x8 kf = *(const bf16x8*)(sK + (32 * k + fr) * QLD + ks * 16 + 8 * h);
          sc[k] = MFMA(kf, qf, sc[k]);
        }
      }
#pragma unroll
      for (int k = 0; k < 4; ++k)
#pragma unroll
        for (int i = 0; i < 16; ++i) {
          int key = __float_as_int(sc[k][i]); key ^= (key >> 31) & 0x7fffffff;
          v[16 * k + i] = (key & ~127) | (127 - (32 * k + crow(i, h)));
        }
    }
#pragma unroll
    for (int k = 2; k <= 16; k <<= 1)
#pragma unroll
      for (int j = k >> 1; j > 0; j >>= 1)
#pragma unroll
        for (int i = 0; i < 64; ++i) { const int l = i ^ j; if (l > i) cex(v[i], v[l], (i & k) != 0); }
    int a[16], bb[16];
#pragma unroll
    for (int i = 0; i < 16; ++i) { a[i] = max(v[i], v[16 + i]); bb[i] = max(v[32 + i], v[48 + i]); }
    merge16(a, false); merge16(bb, true);
#pragma unroll
    for (int i = 0; i < 16; ++i) a[i] = max(a[i], bb[i]);
    merge16(a, true);
#pragma unroll
    for (int i = 0; i < 16; ++i) bb[i] = __shfl_xor(a[i], 32);
#pragma unroll
    for (int i = 0; i < 16; ++i) a[i] = max(a[i], bb[15 - i]);
    merge16(a, true);
    {
      int* dst = TK1 + ((size_t)rt * 256 + 32 * wave + fr) * 256 + hp * 16 + 8 * h;
      int4 o0, o1;
      o0.x = h ? a[8] : a[0]; o0.y = h ? a[9] : a[1]; o0.z = h ? a[10] : a[2]; o0.w = h ? a[11] : a[3];
      o1.x = h ? a[12] : a[4]; o1.y = h ? a[13] : a[5]; o1.z = h ? a[14] : a[6]; o1.w = h ? a[15] : a[7];
      *(int4*)dst = o0; *(int4*)(dst + 4) = o1;
    }
    __syncthreads();
  }
}

DI float key2val(int k) { k &= ~127; k ^= (k >> 31) & 0x7fffffff; return __int_as_float(k); }
DI void phase7(const Params& p) {
  const int* TK1 = (const int*)(p.ws + WS_QD);
  for (int blk = blockIdx.x; blk < NROWS_X * 8 / NT; blk += gridDim.x) {
    const int item = blk * NT + threadIdx.x;
    const int4* src = (const int4*)(TK1 + (size_t)item * 32);
    int ka[16], kb[16];
#pragma unroll
    for (int q = 0; q < 4; ++q) { int4 t = src[q]; ka[4 * q] = t.x; ka[4 * q + 1] = t.y; ka[4 * q + 2] = t.z; ka[4 * q + 3] = t.w; }
#pragma unroll
    for (int q = 0; q < 4; ++q) { int4 t = src[4 + q]; kb[4 * q] = t.x; kb[4 * q + 1] = t.y; kb[4 * q + 2] = t.z; kb[4 * q + 3] = t.w; }
    float cv[50]; int cid[50];
    {
      int n = 0;
#pragma unroll
      for (int i = 0; i < 16; ++i)
#pragma unroll
        for (int j = 0; j < 16; ++j)
          if ((i + 1) * (j + 1) <= 16) {
            cv[n] = key2val(ka[i]) + key2val(kb[j]);
            cid[n] = (127 - (ka[i] & 127)) * 128 + (127 - (kb[j] & 127));
            ++n;
          }
    }
    float best[16]; int bid[16];
#pragma unroll
    for (int r = 0; r < 16; ++r) {
      float mv = cv[0]; int mi = cid[0];
#pragma unroll
      for (int c = 1; c < 50; ++c) if (cv[c] > mv) { mv = cv[c]; mi = cid[c]; }
      best[r] = mv; bid[r] = mi;
#pragma unroll
      for (int c = 0; c < 50; ++c) if (cid[c] == mi) cv[c] = -3.0e38f;
    }
    float sum = 0.f;
#pragma unroll
    for (int r = 15; r >= 0; --r) { best[r] = __expf(best[r] - best[0]); sum += best[r]; }
    const float inv = 1.f / sum;
    unsigned short* ids = (unsigned short*)(p.ws + WS_IDS) + (size_t)item * 16;
    float* gw = (float*)(p.ws + WS_GW) + (size_t)item * 16;
    uint4 i0, i1;
    i0.x = bid[0] | (bid[1] << 16); i0.y = bid[2] | (bid[3] << 16); i0.z = bid[4] | (bid[5] << 16); i0.w = bid[6] | (bid[7] << 16);
    i1.x = bid[8] | (bid[9] << 16); i1.y = bid[10] | (bid[11] << 16); i1.z = bid[12] | (bid[13] << 16); i1.w = bid[14] | (bid[15] << 16);
    *(uint4*)ids = i0; *(uint4*)(ids + 8) = i1;
#pragma unroll
    for (int r = 0; r < 4; ++r) *(float4*)(gw + 4 * r) = make_float4(best[4 * r] * inv, best[4 * r + 1] * inv, best[4 * r + 2] * inv, best[4 * r + 3] * inv);
  }
}

DI void cvt16(const uint4& r, float (&f)[16]) {
  const unsigned w[4] = {r.x, r.y, r.z, r.w};
#pragma unroll
  for (int j = 0; j < 4; ++j) {
    f32x2_t lo = __builtin_amdgcn_cvt_pk_f32_fp8((int)w[j], false), hi = __builtin_amdgcn_cvt_pk_f32_fp8((int)w[j], true);
    f[4 * j] = lo[0]; f[4 * j + 1] = lo[1]; f[4 * j + 2] = hi[0]; f[4 * j + 3] = hi[1];
  }
}
DI void unpack_ids(const uint4& a, const uint4& b, int (&id)[16]) {
  const unsigned w[8] = {a.x, a.y, a.z, a.w, b.x, b.y, b.z, b.w};
#pragma unroll
  for (int j = 0; j < 8; ++j) { id[2 * j] = w[j] & 0xffffu; id[2 * j + 1] = w[j] >> 16; }
}
DI float dpp_f(float v, const int ctrl_sel) {
  const int x = __builtin_bit_cast(int, v);
  int r;
  if (ctrl_sel == 0) r = __builtin_amdgcn_update_dpp(0, x, 0xB1, 0xF, 0xF, true);
  else if (ctrl_sel == 1) r = __builtin_amdgcn_update_dpp(0, x, 0x4E, 0xF, 0xF, true);
  else if (ctrl_sel == 2) r = __builtin_amdgcn_update_dpp(0, x, 0x141, 0xF, 0xF, true);
  else r = __builtin_amdgcn_update_dpp(0, x, 0x128, 0xF, 0xF, true);
  return __builtin_bit_cast(float, r);
}
DI void phase8(const Params& p) {
  const int lane = threadIdx.x & 63, wave = threadIdx.x >> 6, c = lane & 7, s = lane >> 3;
  const int o = blockIdx.x & 7, slot = blockIdx.x >> 3, nslots = gridDim.x >> 3;
  const unsigned char* U8 = (const unsigned char*)(p.ws + WS_U) + 128 * o + 16 * c;
  const unsigned short* IDS = (const unsigned short*)(p.ws + WS_IDS) + 16 * s;
  const short* HX = (const short*)(p.ws + WS_HN) + 128 * o + 16 * c;
  float* PDo = (float*)(p.ws + WS_PD) + (size_t)o * NROWS_X * 128 + 16 * s + 2 * c;
  const int K = (NROWS_X / NW - slot + nslots - 1) / nslots;
  if (K <= 0) return;
  auto tokof = [&](int k) __attribute__((always_inline)) { return (slot + k * nslots) * NW + wave; };
  auto issue = [&](const uint4& pa, const uint4& pb, uint4 (&r)[16]) __attribute__((always_inline)) {
    int id[16]; unpack_ids(pa, pb, id);
#pragma unroll
    for (int j = 0; j < 16; ++j) r[j] = *(const uint4*)(U8 + (size_t)id[j] * 1024);
  };
  auto compute = [&](int tok, const uint4 (&r)[16], const uint4& xa, const uint4& xb) __attribute__((always_inline)) {
    f32x2_t xf[8];
    xf[0] = (f32x2_t){bflo(xa.x), bfhi(xa.x)}; xf[1] = (f32x2_t){bflo(xa.y), bfhi(xa.y)}; xf[2] = (f32x2_t){bflo(xa.z), bfhi(xa.z)}; xf[3] = (f32x2_t){bflo(xa.w), bfhi(xa.w)};
    xf[4] = (f32x2_t){bflo(xb.x), bfhi(xb.x)}; xf[5] = (f32x2_t){bflo(xb.y), bfhi(xb.y)}; xf[6] = (f32x2_t){bflo(xb.z), bfhi(xb.z)}; xf[7] = (f32x2_t){bflo(xb.w), bfhi(xb.w)};
    float d[16];
#pragma unroll
    for (int j = 0; j < 16; ++j) {
      const unsigned w[4] = {r[j].x, r[j].y, r[j].z, r[j].w};
      f32x2_t a2 = {0.f, 0.f};
#pragma unroll
      for (int q = 0; q < 4; ++q) {
        a2 += __builtin_amdgcn_cvt_pk_f32_fp8((int)w[q], false) * xf[2 * q];
        a2 += __builtin_amdgcn_cvt_pk_f32_fp8((int)w[q], true) * xf[2 * q + 1];
      }
      float t = a2[0] + a2[1];
      t += dpp_f(t, 0); t += dpp_f(t, 1); t += dpp_f(t, 2);
      d[j] = t;
    }
    float2 o2 = make_float2(d[0], d[1]);
#pragma unroll
    for (int j = 1; j < 8; ++j) if (c == j) o2 = make_float2(d[2 * j], d[2 * j + 1]);
    *(float2*)(PDo + (size_t)tok * 128) = o2;
  };
  auto ldids = [&](int tok, uint4& a, uint4& b) __attribute__((always_inline)) { a = *(const uint4*)(IDS + (size_t)tok * 128); b = *(const uint4*)(IDS + (size_t)tok * 128 + 8); };
  auto ldx = [&](int tok, uint4& a, uint4& b) __attribute__((always_inline)) { a = *(const uint4*)(HX + (size_t)tok * DM); b = *(const uint4*)(HX + (size_t)tok * DM + 8); };
  uint4 rA[16], rB[16], i0a, i0b, i1a, i1b, x0a, x0b, x1a, x1b;
  ldids(tokof(0), i0a, i0b); ldx(tokof(0), x0a, x0b);
  i1a = i0a; i1b = i0b; x1a = x0a; x1b = x0b;
  if (K > 1) ldids(tokof(1), i1a, i1b);
  issue(i0a, i0b, rA);
  for (int k = 0; k < K; k += 2) {
    if (k + 1 < K) { issue(i1a, i1b, rB); ldx(tokof(k + 1), x1a, x1b); }
    if (k + 2 < K) ldids(tokof(k + 2), i0a, i0b);
    compute(tokof(k), rA, x0a, x0b);
    if (k + 1 >= K) break;
    if (k + 2 < K) { issue(i0a, i0b, rA); ldx(tokof(k + 2), x0a, x0b); }
    if (k + 3 < K) ldids(tokof(k + 3), i1a, i1b);
    compute(tokof(k + 1), rB, x1a, x1b);
  }
}
DI void phase9(const Params& p) {
  const float* PD = (const float*)(p.ws + WS_PD);
  float* GW = (float*)(p.ws + WS_GW);
  const unsigned short* IDS = (const unsigned short*)(p.ws + WS_IDS);
  const float* SV = (const float*)(p.ws + WS_SV);
  const float* SU = (const float*)(p.ws + WS_SU);
  for (int blk = blockIdx.x; blk < NROWS_X * 128 / NT; blk += gridDim.x) {
    const size_t idx = (size_t)blk * NT + threadIdx.x;
    float d = 0.f;
#pragma unroll
    for (int o = 0; o < 8; ++o) d += PD[(size_t)o * NROWS_X * 128 + idx];
    const int id = IDS[idx];
    d *= SU[id];
    const float a = 0.5f * d * (1.f + erff(d * 0.70710678118654752f));
    GW[idx] = GW[idx] * a * SV[id];
  }
}
DI void phase10(const Params& p) {
  const int lane = threadIdx.x & 63, wave = threadIdx.x >> 6, c = lane & 7, s = lane >> 3;
  const int o = blockIdx.x & 7, slot = blockIdx.x >> 3, nslots = gridDim.x >> 3;
  const unsigned char* V8 = (const unsigned char*)(p.ws + WS_V) + 128 * o + 16 * c;
  const float* mod = (const float*)(p.ws + WS_MOD);
  const unsigned short* IDS = (const unsigned short*)(p.ws + WS_IDS) + 16 * s;
  const float* GW = (const float*)(p.ws + WS_GW) + 16 * s;
  const int col = 128 * o + 16 * c + 2 * s;
  const int K = (NROWS_X / NW - slot + nslots - 1) / nslots;
  if (K <= 0) return;
  const bool b2 = (s & 4) != 0, b1 = (s & 2) != 0, b0 = (s & 1) != 0;
  auto tokof = [&](int k) __attribute__((always_inline)) { return (slot + k * nslots) * NW + wave; };
  auto issue = [&](const uint4& pa, const uint4& pb, uint4 (&r)[16]) __attribute__((always_inline)) {
    int id[16]; unpack_ids(pa, pb, id);
#pragma unroll
    for (int j = 0; j < 16; ++j) r[j] = *(const uint4*)(V8 + (size_t)id[j] * 1024);
  };
  auto compute = [&](int tok, const uint4 (&r)[16], const float (&w)[16]) __attribute__((always_inline)) {
    f32x2_t acc[8];
#pragma unroll
    for (int j = 0; j < 8; ++j) acc[j] = (f32x2_t){0.f, 0.f};
#pragma unroll
    for (int j = 0; j < 16; ++j) {
      const unsigned ww[4] = {r[j].x, r[j].y, r[j].z, r[j].w};
      const f32x2_t w2 = {w[j], w[j]};
#pragma unroll
      for (int q = 0; q < 4; ++q) {
        acc[2 * q] += __builtin_amdgcn_cvt_pk_f32_fp8((int)ww[q], false) * w2;
        acc[2 * q + 1] += __builtin_amdgcn_cvt_pk_f32_fp8((int)ww[q], true) * w2;
      }
    }
    float a[16];
#pragma unroll
    for (int j = 0; j < 8; ++j) { a[2 * j] = acc[j][0]; a[2 * j + 1] = acc[j][1]; }
    float k1[8], k2[4], k3[2];
#pragma unroll
    for (int j = 0; j < 8; ++j) { const float keep = b2 ? a[8 + j] : a[j], send = b2 ? a[j] : a[8 + j]; k1[j] = keep + __shfl_xor(send, 32); }
#pragma unroll
    for (int j = 0; j < 4; ++j) { const float keep = b1 ? k1[4 + j] : k1[j], send = b1 ? k1[j] : k1[4 + j]; k2[j] = keep + __shfl_xor(send, 16); }
#pragma unroll
    for (int j = 0; j < 2; ++j) { const float keep = b0 ? k2[2 + j] : k2[j], send = b0 ? k2[j] : k2[2 + j]; k3[j] = keep + dpp_f(send, 3); }
    const int b = tok / SEQ;
    float* orow = p.out + (size_t)tok * DM + col;
    const float2 xm = *(const float2*)orow, gg = *(const float2*)(mod + b * 6144 + 5120 + col);
    float2 r2; r2.x = xm.x + gg.x * k3[0]; r2.y = xm.y + gg.y * k3[1];
    *(float2*)orow = r2;
    float ss = wave_sum(r2.x * r2.x + r2.y * r2.y);
    if (lane == 0) ((float*)(p.ws + WS_PS))[(size_t)o * NROWS_X + tok] = ss;
  };
  auto ldids = [&](int tok, uint4& a, uint4& b) __attribute__((always_inline)) { a = *(const uint4*)(IDS + (size_t)tok * 128); b = *(const uint4*)(IDS + (size_t)tok * 128 + 8); };
  auto ldw = [&](int tok, float (&w)[16]) __attribute__((always_inline)) {
#pragma unroll
    for (int q = 0; q < 4; ++q) { const float4 t = *(const float4*)(GW + (size_t)tok * 128 + 4 * q); w[4 * q] = t.x; w[4 * q + 1] = t.y; w[4 * q + 2] = t.z; w[4 * q + 3] = t.w; }
  };
  uint4 rA[16], rB[16], i0a, i0b, i1a, i1b; float w0[16], w1[16];
  ldids(tokof(0), i0a, i0b); ldw(tokof(0), w0);
  i1a = i0a; i1b = i0b;
#pragma unroll
  for (int q = 0; q < 16; ++q) w1[q] = w0[q];
  if (K > 1) ldids(tokof(1), i1a, i1b);
  issue(i0a, i0b, rA);
  for (int k = 0; k < K; k += 2) {
    if (k + 1 < K) { issue(i1a, i1b, rB); ldw(tokof(k + 1), w1); }
    if (k + 2 < K) ldids(tokof(k + 2), i0a, i0b);
    compute(tokof(k), rA, w0);
    if (k + 1 >= K) break;
    if (k + 2 < K) { issue(i0a, i0b, rA); ldw(tokof(k + 2), w0); }
    if (k + 3 < K) ldids(tokof(k + 3), i1a, i1b);
    compute(tokof(k + 1), rB, w1);
  }
}
DI void phase11(const Params& p) {
  const int lane = threadIdx.x & 63, wave = threadIdx.x >> 6;
  const float* PS = (const float*)(p.ws + WS_PS);
  for (int g = blockIdx.x; g < NROWS_X / NW; g += gridDim.x) {
    const int tok = g * NW + wave;
    float ss = 0.f;
#pragma unroll
    for (int o = 0; o < 8; ++o) ss += PS[(size_t)o * NROWS_X + tok];
    const float rinv = rsqrtf(ss * (1.f / 1024.f) + EPS);
    float* orow = p.out + (size_t)tok * DM;
#pragma unroll
    for (int j = 0; j < 4; ++j) {
      const int d = 4 * (lane + 64 * j);
      const float4 v = *(const float4*)(orow + d), fg = *(const float4*)(p.fng + d);
      *(float4*)(orow + d) = make_float4(v.x * rinv * fg.x, v.y * rinv * fg.y, v.z * rinv * fg.z, v.w * rinv * fg.w);
    }
  }
}

#define WS_BAR WS_END
#define XB_TMO      128
#define XB_XCNT(j)  (256  + 64 * (j))
#define XB_XSUB(j)  (1280 + 64 * (j))
#define XB_XGEN(j)  (2304 + 64 * (j))
#define XB_TOP      3328
#define XB_TOPGEN   3392
#define XCD_BAR_WORDS 3456
#define XB_SPIN_CAP (1u << 18)
#define LAS __attribute__((address_space(3)))

__device__ __forceinline__ unsigned xb_ld(unsigned* p)              { return __hip_atomic_load(p, __ATOMIC_RELAXED, __HIP_MEMORY_SCOPE_AGENT); }
__device__ __forceinline__ unsigned xb_add(unsigned* p, unsigned v) { return __hip_atomic_fetch_add(p, v, __ATOMIC_RELAXED, __HIP_MEMORY_SCOPE_AGENT); }
__device__ __forceinline__ unsigned xb_xcc_id() { return (unsigned)__builtin_amdgcn_s_getreg((3 << 11) | 20) & 0xFu; }
#define XB_SPIN(cond, bar) do { unsigned _sp = 0; while (cond) { __builtin_amdgcn_s_sleep(1); \
    if ((++_sp & 255u) == 0u) { if (xb_ld(&(bar)[XB_TMO])) break; if (_sp > XB_SPIN_CAP) { atomicAdd(&(bar)[XB_TMO], 1u); break; } } } } while (0)

struct XcdBarrier {
    unsigned* bar; unsigned x;
    volatile LAS unsigned* st;
};

__device__ __forceinline__ XcdBarrier xcd_barrier_post(unsigned* bar, volatile LAS unsigned* st) {
    XcdBarrier b; b.bar = bar; b.x = xb_xcc_id(); b.st = st;
    if (threadIdx.x == 0) (void)xb_add(&bar[XB_XCNT(b.x)], 1u);
    return b;
}
__device__ __forceinline__ void xcd_barrier_complete(unsigned* bar, unsigned x, unsigned& nloc, unsigned& nx) {
    const unsigned G = gridDim.x * gridDim.y * gridDim.z;
    unsigned sum, cnt, mine, sp = 0u;
    for (;;) {
        sum = 0u; cnt = 0u; mine = 0u;
#pragma unroll
        for (unsigned j = 0; j < 16; ++j) { const unsigned c = xb_ld(&bar[XB_XCNT(j)]); sum += c; cnt += (c > 0u) ? 1u : 0u; mine = (j == x) ? c : mine; }
        if (sum == G) break;
        __builtin_amdgcn_s_sleep(1);
        if ((++sp & 255u) == 0u) { if (xb_ld(&bar[XB_TMO])) break; if (sp > XB_SPIN_CAP) { atomicAdd(&bar[XB_TMO], 1u); break; } }
    }
    nloc = mine > 0u ? mine : 1u; nx = cnt > 0u ? cnt : 1u;
}

__device__ __forceinline__ void xcd_barrier(const XcdBarrier& b) {
    asm volatile("s_waitcnt vmcnt(0)" ::: "memory");
    __syncthreads();
    if (threadIdx.x == 0) {
        unsigned* bar = b.bar;
        __builtin_amdgcn_s_waitcnt(0);
        unsigned nloc = b.st[0], nx = b.st[1];
        if (nloc == 0u) { xcd_barrier_complete(bar, b.x, nloc, nx); b.st[0] = nloc; b.st[1] = nx; }
        const unsigned old = xb_add(&bar[XB_XSUB(b.x)], 1u);
        const unsigned gen = old / nloc;
        if (old + 1u == (gen + 1u) * nloc) {
            __builtin_amdgcn_fence(__ATOMIC_RELEASE, "agent");
            asm volatile("s_waitcnt vmcnt(0)" ::: "memory");
            const unsigned og = xb_add(&bar[XB_TOP], 1u);
            const unsigned tg = og / nx;
            if (og + 1u == (tg + 1u) * nx) xb_add(&bar[XB_TOPGEN], 1u);
            else XB_SPIN(xb_ld(&bar[XB_TOPGEN]) == tg, bar);
            __builtin_amdgcn_fence(__ATOMIC_ACQUIRE, "agent");
            xb_add(&bar[XB_XGEN(b.x)], 1u);
            asm volatile("s_waitcnt vmcnt(0)" ::: "memory");
        } else {
            XB_SPIN(xb_ld(&bar[XB_XGEN(b.x)]) == gen, bar);
            __builtin_amdgcn_fence(__ATOMIC_ACQUIRE, "agent");
            asm volatile("s_waitcnt vmcnt(0)" ::: "memory");
        }
    }
    __syncthreads();
}

#ifndef MINW
#define MINW 2
#endif
#ifndef REP_MASK
#define REP_MASK 0
#endif
#define RUN_PHASE(N, CALL) if (ph_lo <= N && N <= ph_hi) { if (N > ph_lo) xcd_barrier(xb); CALL; if ((REP_MASK >> N) & 1) { xcd_barrier(xb); CALL; } }
__global__ void __launch_bounds__(NT) fwd_kernel(Params p, int ph_lo, int ph_hi) {
  __shared__ __attribute__((aligned(16))) short lds[67584];
  cg::grid_group grid = cg::this_grid();
  if (ph_hi == 0x7fffffff) grid.sync();
  __shared__ uint4 xb_words;
  if (threadIdx.x == 0) xb_words = make_uint4(0u, 0u, 0u, 0u);
  __syncthreads();
  const XcdBarrier xb = xcd_barrier_post((unsigned*)(p.ws + WS_BAR), (volatile LAS unsigned*)&xb_words);
  RUN_PHASE(0, phase0(p, (float*)lds))
  RUN_PHASE(1, phase1(p))
  RUN_PHASE(2, phase2(p, lds))
  RUN_PHASE(3, phase3(p, lds))
  RUN_PHASE(4, phase4(p, lds))
  RUN_PHASE(5, phase5(p))
  RUN_PHASE(6, phase6(p, lds))
  RUN_PHASE(7, phase7(p))
  RUN_PHASE(8, phase8(p))
  RUN_PHASE(9, phase9(p))
  RUN_PHASE(10, phase10(p))
  RUN_PHASE(11, phase11(p))
}

#ifndef N_LAUNCH_MODE
#define N_LAUNCH_MODE 0
#endif

extern "C" void kernel_launch(void* const* d_in, const int* in_sizes, int n_in, void* d_out, int out_size, void* d_ws, size_t ws_size, hipStream_t stream) {
  static int grid_blocks = 0;
  if (!grid_blocks) {
    int dev = 0, cus = 0, per_cu = 0;
    hipGetDevice(&dev);
    hipDeviceGetAttribute(&cus, hipDeviceAttributeMultiprocessorCount, dev);
    hipOccupancyMaxActiveBlocksPerMultiprocessor(&per_cu, fwd_kernel, NT, 0);
    if (per_cu > 1) per_cu = 1;
    if (per_cu < 1) per_cu = 1;
    grid_blocks = cus * per_cu;
  }
  Params p{};
  const float** f = (const float**)&p;
  for (int i = 0; i < 22; ++i) f[i] = (const float*)d_in[i];
  p.out = (float*)d_out;
  p.ws = (char*)d_ws;
#if N_LAUNCH_MODE
  for (int ph = 0; ph <= 11; ++ph) hipLaunchKernelGGL(fwd_kernel, dim3(grid_blocks), dim3(NT), 0, stream, p, ph, ph);
#else
  int lo = 0, hi = 11;
  (void)hipMemsetAsync((char*)d_ws + WS_BAR, 0, XCD_BAR_WORDS * 4, stream);
  void* args[] = {&p, &lo, &hi};
  hipError_t e = hipLaunchCooperativeKernel((void*)fwd_kernel, dim3(grid_blocks), dim3(NT), args, 0, stream);
  if (e != hipSuccess) fprintf(stderr, "cooperative launch failed: %s (grid %d)\n", hipGetErrorString(e), grid_blocks);
#endif
}
```
